# Optimizing an MI355X kernel written in HIP

```python
import jax, jax.numpy as jnp
from jax import lax
import numpy as np

D_MODEL = 2048
BATCH = 1
SEQ = 16384
DEPTH = 1

EPS = 1e-6
GMLP_WIDTH = 1024
GMLP_GROUPS = 8
GMLP_GROUP_DIM = GMLP_WIDTH // GMLP_GROUPS
GMLP_CHUNK = 128
HGRN_HEADS = 8
HGRN_KEY_DIM = 128
HGRN_VAL_DIM = 128
HGRN_QK_WIDTH = HGRN_HEADS * HGRN_KEY_DIM
HGRN_V_WIDTH = HGRN_HEADS * HGRN_VAL_DIM
HGRN_CHUNK = 16
IN_SIZES = (GMLP_WIDTH, GMLP_WIDTH, HGRN_QK_WIDTH, HGRN_QK_WIDTH, HGRN_V_WIDTH, HGRN_V_WIDTH, D_MODEL, D_MODEL)
IN_SPLITS = tuple(int(s) for s in np.cumsum(IN_SIZES)[:-1])
D_IN_PROJ = sum(IN_SIZES)
N_GROUPS = 8
EXPERTS_PER_GROUP = 8
N_EXPERTS = N_GROUPS * EXPERTS_PER_GROUP
EXPERT_TOP_K = 2
D_EXPERT = 1024
MOE_BLOCK = 128

kernel_name = "hybrid_gmlp_hgrn2_hiermoe_block"


def rms_norm(x, g):
    xf = x.astype(jnp.float32)
    y = xf * lax.rsqrt(jnp.mean(xf * xf, axis=-1, keepdims=True) + EPS)
    return (y * g.astype(jnp.float32)).astype(x.dtype)


def layer_norm(x, g, b):
    xf = x.astype(jnp.float32)
    mu = jnp.mean(xf, axis=-1, keepdims=True)
    var = jnp.mean(jnp.square(xf - mu), axis=-1, keepdims=True)
    y = (xf - mu) * lax.rsqrt(var + EPS)
    return (y * g.astype(jnp.float32) + b.astype(jnp.float32)).astype(x.dtype)


def gmlp_branch(u, v, ln_g, ln_b, w_s, b_s):
    bn, s, _ = u.shape
    nc = s // GMLP_CHUNK
    u = jax.nn.gelu(u)
    v = layer_norm(jax.nn.gelu(v), ln_g, ln_b)
    v = v.reshape(bn, nc, GMLP_CHUNK, GMLP_GROUPS, GMLP_GROUP_DIM)
    causal = jnp.tril(jnp.ones((GMLP_CHUNK, GMLP_CHUNK), dtype=bool))
    w = jnp.where(causal[None], w_s, jnp.zeros((), w_s.dtype))
    sv = jnp.einsum('gts,bnsgd->bntgd', w, v) + b_s.T[None, None, :, :, None]
    return u * sv.reshape(bn, s, GMLP_WIDTH)


def hgrn2_branch(q, f_logit, inp, g, lb, norm_g):
    bn, s, _ = q.shape
    H, K, V, C = HGRN_HEADS, HGRN_KEY_DIM, HGRN_VAL_DIM, HGRN_CHUNK
    nc = s // C
    f = lb + (1.0 - lb) * jax.nn.sigmoid(f_logit.astype(jnp.float32))
    log_f = jnp.log(f)
    k = 1.0 - f

    def chunks(t, d):
        return t.reshape(bn, nc, C, H, d).transpose(1, 0, 3, 2, 4)

    qc = chunks(q.astype(jnp.float32), K)
    kc = chunks(k, K)
    ic = chunks(inp.astype(jnp.float32), V)
    a_cum = jnp.cumsum(chunks(log_f, K), axis=3)
    a_last = a_cum[:, :, :, -1, :]

    q_dec = qc * jnp.exp(a_cum)
    k_inv = kc * jnp.exp(-a_cum)
    causal = jnp.tril(jnp.ones((C, C), dtype=bool))
    scores = jnp.einsum('nbhtk,nbhsk->nbhts', q_dec, k_inv)
    scores = jnp.where(causal, scores, 0.0)
    o_intra = jnp.einsum('nbhts,nbhsv->nbhtv', scores, ic)

    k_dec = kc * jnp.exp(a_last[:, :, :, None, :] - a_cum)

    def step(state, xs):
        q_c, k_c, i_c, al = xs
        o = jnp.einsum('bhtk,bhkv->bhtv', q_c, state)
        state = jnp.exp(al)[..., None] * state + jnp.einsum('bhsk,bhsv->bhkv', k_c, i_c)
        return state, o

    s0 = jnp.zeros((bn, H, K, V), jnp.float32)
    _, o_inter = lax.scan(step, s0, (q_dec, k_dec, ic, a_last))
    o = (o_intra + o_inter).transpose(1, 0, 3, 2, 4).reshape(bn, s, H, V)
    o = rms_norm(o, norm_g.reshape(H, V)).reshape(bn, s, H * V)
    return (o * jax.nn.silu(g.astype(jnp.float32))).astype(g.dtype)


def hier_moe(h, w_rg, b_rg, w_re, b_re, w_gate, w_up, w_down):
    bn, s, d = h.shape
    T = bn * s
    ht = h.reshape(T, d)
    g_logits = (ht @ w_rg).astype(jnp.float32) + b_rg.astype(jnp.float32)
    p_group = jax.nn.softmax(g_logits, axis=-1)
    g_sel = jnp.argmax(g_logits, axis=-1).astype(jnp.int32)
    p_g = jnp.take_along_axis(p_group, g_sel[:, None], axis=-1)
    e_logits = ((ht @ w_re).astype(jnp.float32) + b_re.astype(jnp.float32)).reshape(T, N_GROUPS, EXPERTS_PER_GROUP)
    e_in = jnp.take_along_axis(e_logits, g_sel[:, None, None], axis=1)[:, 0]
    top_v, top_i = lax.top_k(e_in, EXPERT_TOP_K)
    gate = jax.nn.softmax(top_v, axis=-1) * p_g

    n_assign = T * EXPERT_TOP_K
    eid = (g_sel[:, None] * EXPERTS_PER_GROUP + top_i.astype(jnp.int32)).reshape(-1)
    tok = jnp.repeat(jnp.arange(T, dtype=jnp.int32), EXPERT_TOP_K)
    wt = gate.reshape(-1)
    order = jnp.argsort(eid)
    e_sorted, tok_sorted, w_sorted = eid[order], tok[order], wt[order]

    counts = jax.ops.segment_sum(jnp.ones_like(eid), eid, num_segments=N_EXPERTS)
    start = jnp.cumsum(counts) - counts
    padded = ((counts + MOE_BLOCK - 1) // MOE_BLOCK) * MOE_BLOCK
    pad_start = jnp.cumsum(padded) - padded
    pad_end = pad_start + padded
    dest = pad_start[e_sorted] + (jnp.arange(n_assign, dtype=jnp.int32) - start[e_sorted])

    n_blocks = (n_assign + N_EXPERTS * (MOE_BLOCK - 1) + MOE_BLOCK - 1) // MOE_BLOCK
    P = n_blocks * MOE_BLOCK
    tok_buf = jnp.full((P,), T, dtype=jnp.int32).at[dest].set(tok_sorted)
    w_buf = jnp.zeros((P,), jnp.float32).at[dest].set(w_sorted)
    block_start = jnp.arange(n_blocks, dtype=jnp.int32) * MOE_BLOCK
    block_e = jnp.minimum(jnp.sum(pad_end[None, :] <= block_start[:, None], axis=1), N_EXPERTS - 1)

    h_pad = jnp.concatenate([ht, jnp.zeros((1, d), ht.dtype)], axis=0)
    xb = h_pad[tok_buf].reshape(n_blocks, MOE_BLOCK, d)

    def expert_block(args):
        xblk, e = args
        a = xblk @ w_gate[e]
        b = xblk @ w_up[e]
        return (jax.nn.silu(a) * b) @ w_down[e]

    yb = lax.map(expert_block, (xb, block_e)).reshape(P, d)
    y = jax.ops.segment_sum(yb * w_buf[:, None].astype(yb.dtype), tok_buf, num_segments=T + 1)[:T]
    return y.reshape(bn, s, d).astype(h.dtype)


def setup_inputs(seed: int = 0) -> dict:
    key = jax.random.key(seed)
    ks = jax.random.split(key, 24)
    f32 = jnp.float32
    L = DEPTH

    def nrm(k, shape, scale):
        return (jax.random.normal(k, shape, f32) * scale).astype(f32)

    return {
        "x": nrm(ks[0], (BATCH, SEQ, D_MODEL), 1.0),
        "norm_mix_g": 1.0 + nrm(ks[1], (L, D_MODEL), 0.02),
        "w_in": nrm(ks[2], (L, D_MODEL, D_IN_PROJ), D_MODEL ** -0.5),
        "gmlp_ln_g": 1.0 + nrm(ks[3], (L, GMLP_WIDTH), 0.02),
        "gmlp_ln_b": nrm(ks[4], (L, GMLP_WIDTH), 0.02),
        "w_spatial": nrm(ks[5], (L, GMLP_GROUPS, GMLP_CHUNK, GMLP_CHUNK), GMLP_CHUNK ** -0.5),
        "b_spatial": 1.0 + nrm(ks[6], (L, GMLP_GROUPS, GMLP_CHUNK), 0.1),
        "hgrn_lb_logits": nrm(ks[7], (L + 1, HGRN_QK_WIDTH), 0.5),
        "hgrn_norm_g": 1.0 + nrm(ks[8], (L, HGRN_V_WIDTH), 0.02),
        "w_branch_a": nrm(ks[9], (L, GMLP_WIDTH, D_MODEL), GMLP_WIDTH ** -0.5),
        "w_branch_b": nrm(ks[10], (L, HGRN_V_WIDTH, D_MODEL), HGRN_V_WIDTH ** -0.5),
        "w_out": nrm(ks[11], (L, D_MODEL, D_MODEL), D_MODEL ** -0.5),
        "norm_ffn_g": 1.0 + nrm(ks[12], (L, D_MODEL), 0.02),
        "w_router_group": nrm(ks[13], (L, D_MODEL, N_GROUPS), D_MODEL ** -0.5),
        "b_router_group": nrm(ks[14], (L, N_GROUPS), 0.01),
        "w_router_expert": nrm(ks[15], (L, D_MODEL, N_EXPERTS), D_MODEL ** -0.5),
        "b_router_expert": nrm(ks[16], (L, N_EXPERTS), 0.01),
        "w_expert_gate": nrm(ks[17], (L, N_EXPERTS, D_MODEL, D_EXPERT), D_MODEL ** -0.5),
        "w_expert_up": nrm(ks[18], (L, N_EXPERTS, D_MODEL, D_EXPERT), D_MODEL ** -0.5),
        "w_expert_down": nrm(ks[19], (L, N_EXPERTS, D_EXPERT, D_MODEL), D_EXPERT ** -0.5),
        "norm_final_g": 1.0 + nrm(ks[20], (D_MODEL,), 0.02),
    }


def reference(x, norm_mix_g, w_in, gmlp_ln_g, gmlp_ln_b, w_spatial, b_spatial, hgrn_lb_logits,
              hgrn_norm_g, w_branch_a, w_branch_b, w_out, norm_ffn_g, w_router_group, b_router_group,
              w_router_expert, b_router_expert, w_expert_gate, w_expert_up, w_expert_down, norm_final_g):
    lb_table = jnp.cumsum(jax.nn.softmax(hgrn_lb_logits.astype(jnp.float32), axis=0), axis=0)
    for l in range(DEPTH):
        h = rms_norm(x, norm_mix_g[l])
        z = h @ w_in[l]
        u, v, q, f_logit, i_in, g_out, gate_a, gate_b = jnp.split(z, IN_SPLITS, axis=-1)
        y_a = gmlp_branch(u, v, gmlp_ln_g[l], gmlp_ln_b[l], w_spatial[l], b_spatial[l])
        y_b = hgrn2_branch(q, f_logit, i_in, g_out, lb_table[l], hgrn_norm_g[l])
        merged = (jax.nn.sigmoid(gate_a) * (y_a @ w_branch_a[l])
                  + jax.nn.sigmoid(gate_b) * (y_b @ w_branch_b[l]))
        x = x + (merged @ w_out[l]).astype(x.dtype)
        h = rms_norm(x, norm_ffn_g[l])
        x = x + hier_moe(h, w_router_group[l], b_router_group[l], w_router_expert[l], b_router_expert[l],
                         w_expert_gate[l], w_expert_up[l], w_expert_down[l])
    return rms_norm(x, norm_final_g)
```

```cpp
#include <hip/hip_runtime.h>
#include <stdint.h>
#include <stdio.h>

namespace {
constexpr int T = 16384, D = 2048, NZ = 10240, GW = 1024, NE = 64, DE = 1024;
constexpr float EPS = 1e-6f;
constexpr int NWAVES = 8, NTHR = 512;
constexpr int PMAX = 32768 + 64 * 256;
constexpr int MT_MAX = PMAX / 256;

#define LAS __attribute__((address_space(3)))
#define GAS __attribute__((address_space(1)))
typedef unsigned short bf16_t;
typedef short bf16x8 __attribute__((ext_vector_type(8)));
typedef short bf16x4 __attribute__((ext_vector_type(4)));
typedef float f32x4 __attribute__((ext_vector_type(4)));
typedef float f32x2 __attribute__((ext_vector_type(2)));
typedef unsigned u32x4 __attribute__((ext_vector_type(4)));
typedef unsigned u32x2 __attribute__((ext_vector_type(2)));

constexpr size_t MiB = 1u << 20;
constexpr size_t WS_CTL = 0, CTL_ZERO_BYTES = 32 * 1024;
constexpr size_t WS_ROWIDX = 2 * MiB;
constexpr size_t WS_SLOTOF = WS_ROWIDX + 256 * 1024;
constexpr size_t WS_TOKE = WS_SLOTOF + 128 * 1024;
constexpr size_t WS_TOKW = WS_TOKE + 128 * 1024;
constexpr size_t WS_SLOTW = WS_TOKW + 128 * 1024;
constexpr size_t WS_RSTD2 = WS_SLOTW + 256 * 1024;
constexpr size_t WS_SLOTRS = WS_RSTD2 + 64 * 1024;
constexpr size_t WS_WRT = 7 * MiB;
constexpr size_t WS_ROWSTAT = 4 * MiB;
constexpr size_t WS_DC = 6 * MiB;
constexpr size_t WS_WTIN = 8 * MiB;
constexpr size_t WS_WTPAB = 48 * MiB;
constexpr size_t WS_WTOUT = 56 * MiB;
constexpr size_t WS_H = 64 * MiB;
constexpr size_t WS_GU = 128 * MiB, WS_GV = 160 * MiB, WS_QB = 192 * MiB, WS_IB = 256 * MiB, WS_SG = 288 * MiB;
constexpr size_t WS_LF = 320 * MiB;
constexpr size_t WS_SGA = 384 * MiB, WS_SGB = 448 * MiB;
constexpr size_t WS_YAB = 512 * MiB;
constexpr size_t WS_HBUF = 576 * MiB;
constexpr size_t WS_SBUF = 640 * MiB;
constexpr size_t WS_LTOK = 640 * MiB, WS_LW = 644 * MiB, WS_LRS = 648 * MiB;
constexpr size_t WS_MERGED = 672 * MiB;
constexpr size_t WS_WGU = 736 * MiB;
constexpr size_t WS_WD = 1248 * MiB;
constexpr size_t WS_END = 1504 * MiB;
constexpr size_t WS_XG = 128 * MiB;
constexpr size_t WS_ACT = 320 * MiB;
constexpr size_t WS_YB = 416 * MiB;
constexpr int CW_COUNTS = 16, CW_CURSOR = 96;
constexpr int CW_BAR = 4096;

constexpr int RING_BYTES = 155648;
constexpr int MISC_OFF = RING_BYTES + 64;
constexpr int LDS_BYTES = RING_BYTES + 1024;

__device__ __forceinline__ float wave_sum(float v) {
#pragma unroll
    for (int o = 32; o >= 1; o >>= 1) v += __shfl_xor(v, o);
    return v;
}
__device__ __forceinline__ unsigned cvt_pk_bf16(float lo, float hi) { unsigned r; asm volatile("v_cvt_pk_bf16_f32 %0, %1, %2" : "=v"(r) : "v"(lo), "v"(hi)); return r; }
__device__ __forceinline__ unsigned cvt_pk_bf16_m(float lo, float hi) { unsigned r; asm volatile("v_cvt_pk_bf16_f32 %0, %1, %2\n\ts_nop 1" : "=v"(r) : "v"(lo), "v"(hi)); return r; }
__device__ __forceinline__ unsigned cvt_pk_bf16_d(float lo, float hi) { unsigned r; asm volatile("s_nop 7\n\ts_nop 3\n\tv_cvt_pk_bf16_f32 %0, %1, %2\n\ts_nop 1" : "=v"(r) : "v"(lo), "v"(hi)); return r; }
__device__ __forceinline__ float bf_lo(unsigned w) { return __uint_as_float(w << 16); }
__device__ __forceinline__ float bf_hi(unsigned w) { return __uint_as_float(w & 0xffff0000u); }
__device__ __forceinline__ float bf2f(bf16_t b) { return __uint_as_float(((unsigned)b) << 16); }
__device__ __forceinline__ float fast_sigmoid(float x) { return __builtin_amdgcn_rcpf(1.f + __builtin_amdgcn_exp2f(-1.4426950408889634f * x)); }
__device__ __forceinline__ float fast_gelu(float x) { const float u = x * (0.7978845608028654f + 0.035677408136300125f * x * x); return x * __builtin_amdgcn_rcpf(1.f + __builtin_amdgcn_exp2f(-2.8853900817779268f * u)); }
__device__ __forceinline__ float fast_exp(float x) { return __builtin_amdgcn_exp2f(1.4426950408889634f * x); }
__device__ __forceinline__ float fast_log(float x) { return 0.6931471805599453f * __builtin_amdgcn_logf(x); }
__device__ __forceinline__ float clamp448(float v) { return __builtin_fminf(__builtin_fmaxf(v, -448.f), 448.f); }
__device__ __forceinline__ unsigned pk4_fp8(float a, float b, float c, float d) { int r = __builtin_amdgcn_cvt_pk_fp8_f32(a, b, 0, false); r = __builtin_amdgcn_cvt_pk_fp8_f32(c, d, r, true); return (unsigned)r; }
namespace pg8 {
constexpr int BM = 256, BK = 64, HALF = 128, HTB = HALF * BK * 2, STAGE_BYTES = 8 * HTB, NXCD = 8, WGM = 4;
__host__ __device__ __forceinline__ int lds_byte(int r, int c) { const int st = (r >> 4) * 2 + (c >> 5), rr = r & 15, cc = c & 31, ob = rr * 64 + cc * 2; return st * 1024 + (ob ^ (((ob >> 9) & 1) << 5)); }
__host__ __device__ __forceinline__ void stage_rc(int b, int& R, int& C) { const int st = b / 1024, sb = b % 1024, swz = sb ^ (((sb >> 9) & 1) << 5); R = (st >> 1) * 16 + swz / 64; C = (st & 1) * 32 + (swz % 64) / 2; }
__host__ __device__ __forceinline__ int perm32(int rho) { const int n = rho >> 4, i = rho & 15; return 8 * (i >> 2) + 4 * n + (i & 3); }

struct Unit { const char* A; const char* B; int pm, pn, aux; };
struct Shape { int K, lda, ldb; };

struct StaticOrder {
    const char* A; const char* Bt; size_t a_tile, b_tile; int nM, nN, nwg, G, c;
    __device__ void init(const void* A_, const void* Bt_, int M, int N, int lda, int ldb, int G_, int c_) { A = (const char*)A_; Bt = (const char*)Bt_; a_tile = (size_t)BM * lda * 2; b_tile = (size_t)BM * ldb * 2; nM = M / BM; nN = N / BM; nwg = nM * nN; G = G_; c = c_; }
    __device__ bool next(int i, Unit& u) const {
        const long L = (long)i * G + c; if (L >= nwg) return false;
        int wgid = (int)L; { const int q = nwg / NXCD, r = nwg % NXCD, xcd = wgid % NXCD, off = wgid / NXCD; wgid = (xcd < r ? xcd * (q + 1) : r * (q + 1) + (xcd - r) * q) + off; }
        const int nig = WGM * nN, gid = wgid / nig, fm = gid * WGM, gsz = (nM - fm) < WGM ? (nM - fm) : WGM;
        u.pm = fm + ((wgid % nig) % gsz); u.pn = (wgid % nig) / gsz; u.aux = 0;
        u.A = A + (size_t)u.pm * a_tile; u.B = Bt + (size_t)u.pn * b_tile; return true;
    }
};

template <class Epi, class Sched>
__device__ __forceinline__ void gemm_phase(LAS unsigned char* lds, const Shape g, const Sched& S, const Epi& E) {
    const int tid = threadIdx.x, wid = __builtin_amdgcn_readfirstlane(tid >> 6), lane = tid & 63, wr = wid >> 2, wc = wid & 3, fr = lane & 15, fq = lane >> 4;
    const int K = g.K, nt = K / BK;
    unsigned voffA[2], voffB[2];
#pragma unroll
    for (int i = 0; i < 2; ++i) { int R, C; stage_rc(tid * 16 + i * 8192, R, C); const int Rb = Epi::PERM ? ((R & ~31) + perm32(R & 31)) : R;
        voffA[i] = (unsigned)(R * g.lda + C) * 2u; voffB[i] = (unsigned)(Rb * g.ldb + C) * 2u; }
    const size_t kstep = (size_t)(BK * 2);
    const size_t hstepA = (size_t)HALF * g.lda * 2, hstepB = (size_t)HALF * g.ldb * 2;
    const unsigned ldsw = (unsigned)wid * 1024u;
    const int aoff = lds_byte(wr * 64 + fr, fq * 8), boff = lds_byte(wc * 32 + fr, fq * 8);
#define PG8_SA(b, h) (((b) * 2 + (h)) * HTB)
#define PG8_SB(b, h) ((4 + (b) * 2 + (h)) * HTB)
#define PG8_STAGE(bufoff, gbase, voff) do { _Pragma("unroll") for (int _i = 0; _i < 2; ++_i) \
        __builtin_amdgcn_global_load_lds((const unsigned*)((const char*)(gbase) + (voff)[_i]), (LAS unsigned*)(lds + (bufoff) + ldsw + _i * 8192), 16, 0, 0); } while (0)
#define PG8_LDA(dst, b, h) do { _Pragma("unroll") for (int m = 0; m < 4; ++m) _Pragma("unroll") for (int k = 0; k < 2; ++k) dst[m][k] = *(const LAS bf16x8*)(lds + PG8_SA(b, h) + aoff + m * 2048 + k * 1024); } while (0)
#define PG8_LDB(dst, b, h) do { _Pragma("unroll") for (int n = 0; n < 2; ++n) _Pragma("unroll") for (int k = 0; k < 2; ++k) dst[n][k] = *(const LAS bf16x8*)(lds + PG8_SB(b, h) + boff + n * 2048 + k * 1024); } while (0)
#define PG8_MMA(ai, bj, At, Bt) do { __builtin_amdgcn_s_setprio(1); _Pragma("unroll") for (int m = 0; m < 4; ++m) _Pragma("unroll") for (int n = 0; n < 2; ++n) _Pragma("unroll") for (int k = 0; k < 2; ++k) \
        acc[ai][bj][m][n] = __builtin_amdgcn_mfma_f32_16x16x32_bf16(Bt[n][k], At[m][k], acc[ai][bj][m][n], 0, 0, 0); __builtin_amdgcn_s_setprio(0); } while (0)
#define PG8_WAIT_V(n) asm volatile("s_waitcnt vmcnt(" #n ")" ::: "memory")
#define PG8_WAIT_L(n) asm volatile("s_waitcnt lgkmcnt(" #n ")" ::: "memory")
#define PG8_BAR __builtin_amdgcn_s_barrier()
#define PG8_SCHED __builtin_amdgcn_sched_barrier(0)
    Unit cur, nxt; int ui = 0;
    if (!S.next(0, cur)) return;
    f32x4 acc[2][2][4][2];
#pragma unroll
    for (int a = 0; a < 2; ++a)
#pragma unroll
        for (int b = 0; b < 2; ++b)
#pragma unroll
            for (int m = 0; m < 4; ++m)
#pragma unroll
                for (int n = 0; n < 2; ++n) acc[a][b][m][n] = (f32x4){0.f, 0.f, 0.f, 0.f};
    bf16x8 At[4][2], B0[2][2], B1[2][2];
    const char* cA = cur.A; const char* cB = cur.B;
    PG8_STAGE(PG8_SB(0, 0), cB, voffB); PG8_STAGE(PG8_SB(0, 1), cB + hstepB, voffB); PG8_STAGE(PG8_SA(0, 0), cA, voffA); PG8_STAGE(PG8_SA(0, 1), cA + hstepA, voffA);
    if (wr == 1) PG8_BAR;
    PG8_WAIT_V(2); PG8_BAR;
    PG8_STAGE(PG8_SB(1, 0), cB + kstep, voffB); PG8_STAGE(PG8_SA(1, 0), cA + kstep, voffA); PG8_STAGE(PG8_SB(1, 1), cB + hstepB + kstep, voffB);
    PG8_WAIT_V(6); PG8_BAR;
    for (;;) {
        const bool has_next = S.next(ui + 1, nxt);
        const char* nA = has_next ? nxt.A : cA; const char* nB = has_next ? nxt.B : cB;
        for (int t = 0; t < nt; t += 2) {
            const bool last = (t == nt - 2);
            const char* a1 = cA + (size_t)(t + 1) * kstep;
            const char* a2 = last ? nA : cA + (size_t)(t + 2) * kstep; const char* b2 = last ? nB : cB + (size_t)(t + 2) * kstep;
            const char* a3 = a2 + kstep; const char* b3 = b2 + kstep;
            if constexpr (Epi::HAS_MID) { if (t == nt / 2) E.mid(acc, cur, wr, wc, fr, fq); }
            PG8_LDB(B0, 0, 0); PG8_LDB(B1, 0, 1); PG8_SCHED; PG8_LDA(At, 0, 0); PG8_STAGE(PG8_SA(1, 1), a1 + hstepA, voffA);
            PG8_WAIT_V(8); PG8_WAIT_L(0); PG8_BAR; PG8_MMA(0, 0, At, B0); PG8_MMA(0, 1, At, B1); PG8_BAR; PG8_SCHED;
            PG8_LDA(At, 0, 1); PG8_STAGE(PG8_SB(0, 0), b2, voffB); PG8_STAGE(PG8_SB(0, 1), b2 + hstepB, voffB); PG8_STAGE(PG8_SA(0, 0), a2, voffA);
            PG8_WAIT_V(8); PG8_WAIT_L(0); PG8_BAR; PG8_MMA(1, 0, At, B0); PG8_MMA(1, 1, At, B1); PG8_BAR; PG8_SCHED;
            PG8_LDB(B0, 1, 0); PG8_LDB(B1, 1, 1); PG8_SCHED; PG8_LDA(At, 1, 0); PG8_STAGE(PG8_SA(0, 1), a2 + hstepA, voffA);
            PG8_WAIT_V(8); PG8_WAIT_L(0); PG8_BAR; PG8_MMA(0, 0, At, B0); PG8_MMA(0, 1, At, B1); PG8_BAR; PG8_SCHED;
            PG8_LDA(At, 1, 1); PG8_STAGE(PG8_SB(1, 0), b3, voffB); PG8_STAGE(PG8_SB(1, 1), b3 + hstepB, voffB); PG8_STAGE(PG8_SA(1, 0), a3, voffA);
            PG8_WAIT_V(8); PG8_WAIT_L(0); PG8_BAR; PG8_MMA(1, 0, At, B0); PG8_MMA(1, 1, At, B1); PG8_BAR; PG8_SCHED;
        }
        if (wr == 0) PG8_BAR;
        E(acc, cur, wr, wc, fr, fq);
        if (!has_next) break;
#pragma unroll
        for (int a = 0; a < 2; ++a)
#pragma unroll
            for (int b = 0; b < 2; ++b)
#pragma unroll
                for (int m = 0; m < 4; ++m)
#pragma unroll
                    for (int n = 0; n < 2; ++n) acc[a][b][m][n] = (f32x4){0.f, 0.f, 0.f, 0.f};
        cur = nxt; cA = nA; cB = nB; ++ui;
        if (wr == 1) PG8_BAR;
    }
    PG8_WAIT_V(0);
    PG8_BAR;
#undef PG8_SA
#undef PG8_SB
#undef PG8_STAGE
#undef PG8_LDA
#undef PG8_LDB
#undef PG8_MMA
#undef PG8_WAIT_V
#undef PG8_WAIT_L
#undef PG8_BAR
#undef PG8_SCHED
}
}
struct EpiZ {
    static constexpr bool PERM = true, HAS_MID = false;
    unsigned char* ws; const float* lbl;
    __device__ __forceinline__ void mid(f32x4 (&)[2][2][4][2], const pg8::Unit&, int, int, int, int) const {}
    __device__ __forceinline__ void operator()(const f32x4 (&acc)[2][2][4][2], const pg8::Unit& u, int wr, int wc, int fr, int fq) const {
        const int pn = u.pn, row0 = u.pm * 256 + wr * 64 + fr;
        int kind, ldc, c0; bf16_t* base = nullptr;
        if (pn < 24) { const int seg = pn >> 2; c0 = (pn & 3) * 256 + wc * 32 + 8 * fq; ldc = 1024; kind = seg;
            base = (bf16_t*)(ws + WS_GU + (size_t)seg * (32 * MiB)); }
        else { kind = 6; ldc = 2048; c0 = ((pn - 24) & 7) * 256 + wc * 32 + 8 * fq; base = (bf16_t*)(ws + WS_SGA + (size_t)((pn - 24) >> 3) * (64 * MiB)); }
        float* lf = (float*)(ws + WS_LF); f32x2* rowstat = (f32x2*)(ws + WS_ROWSTAT);
        if (kind == 3) {
            float lb[2][8];
#pragma unroll
            for (int bj = 0; bj < 2; ++bj)
#pragma unroll
                for (int j = 0; j < 8; ++j) { const int c = c0 + bj * 128 + j; lb[bj][j] = fast_sigmoid(lbl[c] - lbl[1024 + c]); }
#pragma unroll
            for (int ai = 0; ai < 2; ++ai)
#pragma unroll
                for (int m = 0; m < 4; ++m) { float* rowp = lf + (size_t)(row0 + ai * 128 + m * 16) * 1024 + c0;
#pragma unroll
                    for (int bj = 0; bj < 2; ++bj) { f32x4 o0, o1;
#pragma unroll
                        for (int j = 0; j < 4; ++j) { o0[j] = fast_log(lb[bj][j] + (1.f - lb[bj][j]) * fast_sigmoid(acc[ai][bj][m][0][j])); o1[j] = fast_log(lb[bj][4 + j] + (1.f - lb[bj][4 + j]) * fast_sigmoid(acc[ai][bj][m][1][j])); }
                        *(f32x4*)(rowp + bj * 128) = o0; *(f32x4*)(rowp + bj * 128 + 4) = o1; } }
            return;
        }
#pragma unroll
        for (int ai = 0; ai < 2; ++ai)
#pragma unroll
            for (int m = 0; m < 4; ++m) { const int row = row0 + ai * 128 + m * 16; bf16_t* rowp = base + (size_t)row * ldc + c0; float s1 = 0.f, s2 = 0.f;
#pragma unroll
                for (int bj = 0; bj < 2; ++bj) { f32x4 v0 = acc[ai][bj][m][0], v1 = acc[ai][bj][m][1];
                    if (kind == 0 || kind == 1) {
#pragma unroll
                        for (int j = 0; j < 4; ++j) { v0[j] = fast_gelu(v0[j]); v1[j] = fast_gelu(v1[j]); } }
                    else if (kind == 5) {
#pragma unroll
                        for (int j = 0; j < 4; ++j) { v0[j] = v0[j] * fast_sigmoid(v0[j]); v1[j] = v1[j] * fast_sigmoid(v1[j]); } }
                    else if (kind == 6) {
#pragma unroll
                        for (int j = 0; j < 4; ++j) { v0[j] = fast_sigmoid(v0[j]); v1[j] = fast_sigmoid(v1[j]); } }
                    u32x4 w; w.x = cvt_pk_bf16(v0[0], v0[1]); w.y = cvt_pk_bf16(v0[2], v0[3]); w.z = cvt_pk_bf16(v1[0], v1[1]); w.w = cvt_pk_bf16(v1[2], v1[3]);
                    *(u32x4*)(rowp + bj * 128) = w;
                    if (kind == 1) {
#pragma unroll
                        for (int q = 0; q < 4; ++q) { const float a = bf_lo(w[q]), b = bf_hi(w[q]); s1 += a + b; s2 += a * a + b * b; } }
                }
                if (kind == 1) { s1 += __shfl_xor(s1, 16); s1 += __shfl_xor(s1, 32); s2 += __shfl_xor(s2, 16); s2 += __shfl_xor(s2, 32);
                    if (fq == 0) rowstat[(size_t)row * 16 + (pn & 3) * 4 + wc] = (f32x2){s1, s2}; }
            }
    }
};
struct EpiMerge {
    static constexpr bool PERM = true, HAS_MID = true;
    const bf16_t* sga; const bf16_t* sgb; bf16_t* merged;
    __device__ __forceinline__ void mid(f32x4 (&acc)[2][2][4][2], const pg8::Unit& u, int wr, int wc, int fr, int fq) const {
        int row0 = u.pm * 256 + wr * 64 + fr, c0 = u.pn * 256 + wc * 32 + 8 * fq;
        asm volatile("" : "+v"(row0), "+v"(c0));
#pragma unroll
        for (int ai = 0; ai < 2; ++ai)
#pragma unroll
            for (int m = 0; m < 4; ++m) { const size_t off = (size_t)(row0 + ai * 128 + m * 16) * 2048 + c0;
#pragma unroll
                for (int bj = 0; bj < 2; ++bj) { const u32x4 a8 = *(const u32x4*)(sga + off + bj * 128), b8 = *(const u32x4*)(sgb + off + bj * 128);
#pragma unroll
                    for (int q = 0; q < 4; ++q) { const float rl = bf_lo(a8[q]) * __builtin_amdgcn_rcpf(bf_lo(b8[q])), rh = bf_hi(a8[q]) * __builtin_amdgcn_rcpf(bf_hi(b8[q]));
                        acc[ai][bj][m][q >> 1][(q & 1) * 2] *= rl; acc[ai][bj][m][q >> 1][(q & 1) * 2 + 1] *= rh; } }
                if (m == 3) asm volatile("" ::: "memory"); }
    }
    __device__ __forceinline__ void operator()(const f32x4 (&acc)[2][2][4][2], const pg8::Unit& u, int wr, int wc, int fr, int fq) const {
        const int row0 = u.pm * 256 + wr * 64 + fr, c0 = u.pn * 256 + wc * 32 + 8 * fq;
#pragma unroll
        for (int ai = 0; ai < 2; ++ai)
#pragma unroll
            for (int m = 0; m < 4; ++m) { const size_t off = (size_t)(row0 + ai * 128 + m * 16) * 2048 + c0;
#pragma unroll
                for (int bj = 0; bj < 2; ++bj) { const u32x4 b8 = *(const u32x4*)(sgb + off + bj * 128); const f32x4 v0 = acc[ai][bj][m][0], v1 = acc[ai][bj][m][1];
                    u32x4 w; w.x = cvt_pk_bf16(v0[0] * bf_lo(b8.x), v0[1] * bf_hi(b8.x)); w.y = cvt_pk_bf16(v0[2] * bf_lo(b8.y), v0[3] * bf_hi(b8.y));
                    w.z = cvt_pk_bf16(v1[0] * bf_lo(b8.z), v1[1] * bf_hi(b8.z)); w.w = cvt_pk_bf16(v1[2] * bf_lo(b8.w), v1[3] * bf_hi(b8.w));
                    *(u32x4*)(merged + off + bj * 128) = w; }
                if (m == 3) asm volatile("" ::: "memory"); }
    }
};
struct EpiRes {
    static constexpr bool PERM = true, HAS_MID = false;
    const float* x; bf16_t* x1b;
    __device__ __forceinline__ void mid(f32x4 (&)[2][2][4][2], const pg8::Unit&, int, int, int, int) const {}
    __device__ __forceinline__ void operator()(const f32x4 (&acc)[2][2][4][2], const pg8::Unit& u, int wr, int wc, int fr, int fq) const {
        const int row0 = u.pm * 256 + wr * 64 + fr, c0 = u.pn * 256 + wc * 32 + 8 * fq;
#pragma unroll
        for (int ai = 0; ai < 2; ++ai)
#pragma unroll
            for (int m = 0; m < 4; ++m) { const size_t off = (size_t)(row0 + ai * 128 + m * 16) * D + c0;
#pragma unroll
                for (int bj = 0; bj < 2; ++bj) { const f32x4 xa = *(const f32x4*)(x + off + bj * 128), xb = *(const f32x4*)(x + off + bj * 128 + 4);
                    const f32x4 r0 = xa + acc[ai][bj][m][0], r1 = xb + acc[ai][bj][m][1];
                    u32x4 p; p.x = cvt_pk_bf16(r0[0], r0[1]); p.y = cvt_pk_bf16(r0[2], r0[3]); p.z = cvt_pk_bf16(r1[0], r1[1]); p.w = cvt_pk_bf16(r1[2], r1[3]);
                    *(u32x4*)(x1b + off + bj * 128) = p; }
                if (m == 3) asm volatile("" ::: "memory"); }
    }
};
#define XB_TMO      128
#define XB_XCNT(j)  (256  + 64 * (j))
#define XB_XSUB(j)  (1280 + 64 * (j))
#define XB_XGEN(j)  (2304 + 64 * (j))
#define XB_TOP      3328
#define XB_TOPGEN   3392
#define XCD_BAR_WORDS 3456
#define XB_SPIN_CAP (1u << 18)
__device__ __forceinline__ unsigned xb_ld(unsigned* p)              { return __hip_atomic_load(p, __ATOMIC_RELAXED, __HIP_MEMORY_SCOPE_AGENT); }
__device__ __forceinline__ unsigned xb_add(unsigned* p, unsigned v) { return __hip_atomic_fetch_add(p, v, __ATOMIC_RELAXED, __HIP_MEMORY_SCOPE_AGENT); }
__device__ __forceinline__ unsigned xb_xcc_id() { return (unsigned)__builtin_amdgcn_s_getreg((3 << 11) | 20) & 0xFu; }
#define XB_SPIN(cond, bar) do { unsigned _sp = 0; while (cond) { __builtin_amdgcn_s_sleep(1); \
    if ((++_sp & 255u) == 0u) { if (xb_ld(&(bar)[XB_TMO])) break; if (_sp > XB_SPIN_CAP) { atomicAdd(&(bar)[XB_TMO], 1u); break; } } } } while (0)
struct XcdBarrier { unsigned* bar; unsigned x; volatile LAS unsigned* st; };
__device__ __forceinline__ XcdBarrier xcd_barrier_post(unsigned* bar, volatile LAS unsigned* st) {
    XcdBarrier b; b.bar = bar; b.x = xb_xcc_id(); b.st = st;
    if (threadIdx.x == 0) (void)xb_add(&bar[XB_XCNT(b.x)], 1u);
    return b;
}
__device__ __forceinline__ void xcd_barrier_complete(unsigned* bar, unsigned x, unsigned& nloc, unsigned& nx) {
    const unsigned G = gridDim.x * gridDim.y * gridDim.z;
    unsigned sum, cnt, mine, sp = 0u;
    for (;;) {
        sum = 0u; cnt = 0u; mine = 0u;
#pragma unroll
        for (unsigned j = 0; j < 16; ++j) { const unsigned c = xb_ld(&bar[XB_XCNT(j)]); sum += c; cnt += (c > 0u) ? 1u : 0u; mine = (j == x) ? c : mine; }
        if (sum == G) break;
        __builtin_amdgcn_s_sleep(1);
        if ((++sp & 255u) == 0u) { if (xb_ld(&bar[XB_TMO])) break; if (sp > XB_SPIN_CAP) { atomicAdd(&bar[XB_TMO], 1u); break; } }
    }
    nloc = mine > 0u ? mine : 1u; nx = cnt > 0u ? cnt : 1u;
}
__device__ __forceinline__ void xcd_barrier(const XcdBarrier& b) {
    asm volatile("s_waitcnt vmcnt(0)" ::: "memory");
    __syncthreads();
    if (threadIdx.x == 0) {
        unsigned* bar = b.bar;
        __builtin_amdgcn_s_waitcnt(0);
        unsigned nloc = b.st[0], nx = b.st[1];
        if (nloc == 0u) { xcd_barrier_complete(bar, b.x, nloc, nx); b.st[0] = nloc; b.st[1] = nx; }
        const unsigned old = xb_add(&bar[XB_XSUB(b.x)], 1u);
        const unsigned gen = old / nloc;
        if (old + 1u == (gen + 1u) * nloc) {
            __builtin_amdgcn_fence(__ATOMIC_RELEASE, "agent");
            asm volatile("s_waitcnt vmcnt(0)" ::: "memory");
            const unsigned og = xb_add(&bar[XB_TOP], 1u);
            const unsigned tg = og / nx;
            if (og + 1u == (tg + 1u) * nx) xb_add(&bar[XB_TOPGEN], 1u);
            else XB_SPIN(xb_ld(&bar[XB_TOPGEN]) == tg, bar);
            __builtin_amdgcn_fence(__ATOMIC_ACQUIRE, "agent");
            xb_add(&bar[XB_XGEN(b.x)], 1u);
            asm volatile("s_waitcnt vmcnt(0)" ::: "memory");
        } else {
            XB_SPIN(xb_ld(&bar[XB_XGEN(b.x)]) == gen, bar);
            __builtin_amdgcn_fence(__ATOMIC_ACQUIRE, "agent");
            asm volatile("s_waitcnt vmcnt(0)" ::: "memory");
        }
    }
    __syncthreads();
}

struct Args { const float* in[21]; float* out; unsigned char* ws; int ph_lo, ph_hi; };
struct Frame {
    LAS unsigned char* lds; volatile LAS unsigned* MISC;
    int tid, lane, wave, G, bid;
    const Args* a; unsigned char* ws;
};
#define LDS_WAIT() asm volatile("s_waitcnt lgkmcnt(0)" ::: "memory")

__device__ __forceinline__ void tr_load(f32x4 (&v)[8], const float* src, int ld_src, int lane) {
    const int kr = lane >> 3, nc = (lane & 7) * 4;
#pragma unroll
    for (int i = 0; i < 8; ++i) v[i] = *(const f32x4*)(src + (size_t)(8 * i + kr) * ld_src + nc);
}
__device__ __forceinline__ void tr_store(const f32x4 (&v)[8], bf16_t* dst, int ld_dst, LAS float* scr, int lane) {
    const int kr = lane >> 3, nc = (lane & 7) * 4;
#pragma unroll
    for (int i = 0; i < 8; ++i) { LAS float* s = scr + (8 * i + kr) * 33 + nc; s[0] = v[i][0]; s[1] = v[i][1]; s[2] = v[i][2]; s[3] = v[i][3]; }
    LDS_WAIT();
    const int c = lane & 7, nl = lane >> 3;
#pragma unroll
    for (int j = 0; j < 4; ++j) { const int n = nl + 8 * j; const LAS float* s = scr + (8 * c) * 33 + n;
        u32x4 o; o.x = cvt_pk_bf16(s[0 * 33], s[1 * 33]); o.y = cvt_pk_bf16(s[2 * 33], s[3 * 33]); o.z = cvt_pk_bf16(s[4 * 33], s[5 * 33]); o.w = cvt_pk_bf16(s[6 * 33], s[7 * 33]);
        *(u32x4*)(dst + (size_t)n * ld_dst + 8 * c) = o; }
    LDS_WAIT();
}
struct TrJob { const float* src; bf16_t* dst; int ld_src, ld_dst; };
__device__ __forceinline__ TrJob tr_job(const Frame& F, int it) {
    const Args& a = *F.a; unsigned char* ws = F.ws; TrJob j;
    constexpr int I_IN = (D / 64) * (NZ / 32);
    constexpr int I_PA = (GW / 64) * (D / 32);
    constexpr int I_OUT = (D / 64) * (D / 32);
    constexpr int I_EG = (D / 64) * (DE / 32);
    constexpr int I_ED = (DE / 64) * (D / 32);
    if (it < I_IN) { const int kb = it / (NZ / 32), nb = it % (NZ / 32); j.src = a.in[2] + (size_t)(64 * kb) * NZ + 32 * nb; j.ld_src = NZ; j.dst = (bf16_t*)(ws + WS_WTIN) + (size_t)(32 * nb) * D + 64 * kb; j.ld_dst = D; return j; } it -= I_IN;
    if (it < I_PA) { const int kb = it / (D / 32), nb = it % (D / 32); j.src = a.in[9] + (size_t)(64 * kb) * D + 32 * nb; j.ld_src = D; j.dst = (bf16_t*)(ws + WS_WTPAB) + (size_t)(32 * nb) * 2048 + 64 * kb; j.ld_dst = 2048; return j; } it -= I_PA;
    if (it < I_PA) { const int kb = it / (D / 32), nb = it % (D / 32); j.src = a.in[10] + (size_t)(64 * kb) * D + 32 * nb; j.ld_src = D; j.dst = (bf16_t*)(ws + WS_WTPAB) + (size_t)(32 * nb) * 2048 + 1024 + 64 * kb; j.ld_dst = 2048; return j; } it -= I_PA;
    if (it < I_OUT) { const int kb = it / (D / 32), nb = it % (D / 32); j.src = a.in[11] + (size_t)(64 * kb) * D + 32 * nb; j.ld_src = D; j.dst = (bf16_t*)(ws + WS_WTOUT) + (size_t)(32 * nb) * D + 64 * kb; j.ld_dst = D; return j; } it -= I_OUT;
    const int e = it / (2 * I_EG + I_ED); int r = it % (2 * I_EG + I_ED);
    if (r < 2 * I_EG) { const int up = r >= I_EG; if (up) r -= I_EG; const int kb = r / (DE / 32), nb = r % (DE / 32); const int n0 = 32 * nb;
        j.src = (up ? a.in[18] : a.in[17]) + (size_t)e * D * DE + (size_t)(64 * kb) * DE + n0; j.ld_src = DE;
        j.dst = (bf16_t*)(ws + WS_WGU) + ((size_t)e * 2048 + (n0 >> 7) * 256 + (n0 & 127) + (up ? 128 : 0)) * 2048 + 64 * kb; j.ld_dst = 2048; return j; }
    r -= 2 * I_EG; { const int kb = r / (D / 32), nb = r % (D / 32);
        j.src = a.in[19] + (size_t)e * DE * D + (size_t)(64 * kb) * D + 32 * nb; j.ld_src = D;
        j.dst = (bf16_t*)(ws + WS_WD) + ((size_t)e * 2048 + 32 * nb) * 1024 + 64 * kb; j.ld_dst = 1024; return j; }
}
constexpr int TR_ITEMS_SMALL = (D / 64) * (NZ / 32) + 2 * (GW / 64) * (D / 32) + (D / 64) * (D / 32);
constexpr int TR_ITEMS_ALL = TR_ITEMS_SMALL + NE * 3 * 1024;

__device__ __forceinline__ void rms_row_to_bf16(const float* xrow, const float* g, bf16_t* orow, int lane) {
    const f32x4* xr = (const f32x4*)xrow + lane;
    f32x4 v[8]; float s = 0.f;
#pragma unroll
    for (int j = 0; j < 8; ++j) { v[j] = xr[64 * j]; s += (v[j][0] * v[j][0] + v[j][1] * v[j][1]) + (v[j][2] * v[j][2] + v[j][3] * v[j][3]); }
    const float r = rsqrtf(wave_sum(s) * (1.f / D) + EPS);
    u32x2* o8 = (u32x2*)orow + lane;
#pragma unroll
    for (int j = 0; j < 8; ++j) { const f32x4 gg = ((const f32x4*)g)[lane + 64 * j]; u32x2 w; w.x = cvt_pk_bf16(v[j][0] * r * gg[0], v[j][1] * r * gg[1]); w.y = cvt_pk_bf16(v[j][2] * r * gg[2], v[j][3] * r * gg[3]); o8[64 * j] = w; }
}
__device__ __forceinline__ void p0_prologue(Frame& F, int n_items) {
    LAS float* scr = (LAS float*)(F.lds + F.wave * 8448);
    const int gw = F.bid * NWAVES + F.wave, NGW = F.G * NWAVES;
    f32x4 va[8], vb[8];
    int it = gw;
    TrJob ja, jb;
    if (it < n_items) { ja = tr_job(F, it); tr_load(va, ja.src, ja.ld_src, F.lane); }
    while (it < n_items) {
        const int itb = it + NGW;
        if (itb < n_items) { jb = tr_job(F, itb); tr_load(vb, jb.src, jb.ld_src, F.lane); }
        tr_store(va, ja.dst, ja.ld_dst, scr, F.lane);
        const int itc = itb + NGW;
        if (itc < n_items) { ja = tr_job(F, itc); tr_load(va, ja.src, ja.ld_src, F.lane); }
        if (itb < n_items) tr_store(vb, jb.dst, jb.ld_dst, scr, F.lane);
        it = itc;
    }
    for (int m = gw; m < T; m += 2 * NGW) {
        const int mb = m + NGW < T ? m + NGW : m; const int lane = F.lane;
        const f32x4* xa = (const f32x4*)(F.a->in[0] + (size_t)m * D) + lane; const f32x4* xb = (const f32x4*)(F.a->in[0] + (size_t)mb * D) + lane;
        f32x4 va[8], vb[8]; float sa = 0.f, sb = 0.f;
#pragma unroll
        for (int j = 0; j < 8; ++j) { va[j] = xa[64 * j]; vb[j] = xb[64 * j]; }
#pragma unroll
        for (int j = 0; j < 8; ++j) { sa += (va[j][0] * va[j][0] + va[j][1] * va[j][1]) + (va[j][2] * va[j][2] + va[j][3] * va[j][3]); sb += (vb[j][0] * vb[j][0] + vb[j][1] * vb[j][1]) + (vb[j][2] * vb[j][2] + vb[j][3] * vb[j][3]); }
        const float ra = rsqrtf(wave_sum(sa) * (1.f / D) + EPS), rb = rsqrtf(wave_sum(sb) * (1.f / D) + EPS);
        u32x2* oa = (u32x2*)((bf16_t*)(F.ws + WS_H) + (size_t)m * D) + lane; u32x2* ob = (u32x2*)((bf16_t*)(F.ws + WS_H) + (size_t)mb * D) + lane;
#pragma unroll
        for (int j = 0; j < 8; ++j) { const f32x4 gg = ((const f32x4*)F.a->in[1])[lane + 64 * j]; u32x2 wa, wb;
            wa.x = cvt_pk_bf16(va[j][0] * ra * gg[0], va[j][1] * ra * gg[1]); wa.y = cvt_pk_bf16(va[j][2] * ra * gg[2], va[j][3] * ra * gg[3]);
            wb.x = cvt_pk_bf16(vb[j][0] * rb * gg[0], vb[j][1] * rb * gg[1]); wb.y = cvt_pk_bf16(vb[j][2] * rb * gg[2], vb[j][3] * rb * gg[3]);
            oa[64 * j] = wa; if (mb != m) ob[64 * j] = wb; }
    }
}
__device__ __forceinline__ f32x4 mfma16(bf16x8 a, bf16x8 b, f32x4 c) { return __builtin_amdgcn_mfma_f32_16x16x32_bf16(a, b, c, 0, 0, 0); }
constexpr int TP = 272;
constexpr int AP = 528;

template <class XF>
__device__ __forceinline__ void build_transposed(LAS unsigned char* dstT, const bf16_t* src, int ld, int tid, const XF& xf) {
#pragma unroll
    for (int it = 0; it < 2; ++it) {
        const int bi = tid + 512 * it, sb = bi >> 5, db = bi & 31, s0 = 4 * sb, d0 = 4 * db;
        u32x2 r[4];
#pragma unroll
        for (int q = 0; q < 4; ++q) r[q] = *(const u32x2*)(src + (size_t)(s0 + q) * ld + d0);
        float v[4][4];
#pragma unroll
        for (int q = 0; q < 4; ++q) { v[q][0] = xf(bf_lo(r[q].x), s0 + q, d0); v[q][1] = xf(bf_hi(r[q].x), s0 + q, d0 + 1); v[q][2] = xf(bf_lo(r[q].y), s0 + q, d0 + 2); v[q][3] = xf(bf_hi(r[q].y), s0 + q, d0 + 3); }
#pragma unroll
        for (int i = 0; i < 4; ++i) { u32x2 w; w.x = cvt_pk_bf16(v[0][i], v[1][i]); w.y = cvt_pk_bf16(v[2][i], v[3][i]); *(LAS u32x2*)(dstT + (d0 + i) * TP + s0 * 2) = w; }
    }
}

__device__ __forceinline__ void gmlp_phase(Frame& F) {
    const Args& a = *F.a; unsigned char* ws = F.ws;
    LAS unsigned char* Wb = F.lds;
    LAS unsigned char* vT = F.lds + 128 * TP;
    LAS float* st_mu = (LAS float*)(F.lds + 2 * 128 * TP);
    LAS float* st_rs = st_mu + 128;
    LAS float* lng = st_rs + 128; LAS float* lnb = lng + 128;
    const int tid = F.tid, lane = F.lane, w = F.wave, g4 = lane >> 4, l15 = lane & 15;
    const bf16_t* gu = (const bf16_t*)(ws + WS_GU); const bf16_t* gv = (const bf16_t*)(ws + WS_GV); const f32x2* rowstat = (const f32x2*)(ws + WS_ROWSTAT);
    bf16_t* yab = (bf16_t*)(ws + WS_YAB);
    int cur_g = -1;
    for (int u = F.bid; u < 1024; u += F.G) {
        const int c = u >> 3, g = u & 7, t0 = c * 128;
        __syncthreads();
        if (g != cur_g) {
            cur_g = g;
            const int t = tid >> 2, sq = (tid & 3) * 32; const float* wr = a.in[5] + ((size_t)g * 128 + t) * 128 + sq;
#pragma unroll
            for (int q = 0; q < 4; ++q) { const f32x4 x0 = *(const f32x4*)(wr + 8 * q), x1 = *(const f32x4*)(wr + 8 * q + 4); const int s = sq + 8 * q;
                u32x4 o; o.x = cvt_pk_bf16(s + 0 <= t ? x0[0] : 0.f, s + 1 <= t ? x0[1] : 0.f); o.y = cvt_pk_bf16(s + 2 <= t ? x0[2] : 0.f, s + 3 <= t ? x0[3] : 0.f);
                o.z = cvt_pk_bf16(s + 4 <= t ? x1[0] : 0.f, s + 5 <= t ? x1[1] : 0.f); o.w = cvt_pk_bf16(s + 6 <= t ? x1[2] : 0.f, s + 7 <= t ? x1[3] : 0.f);
                *(LAS u32x4*)(Wb + t * TP + s * 2) = o; }
            if (tid < 128) { lng[tid] = a.in[3][g * 128 + tid]; lnb[tid] = a.in[4][g * 128 + tid]; }
        }
        if (tid < 128) { float s1 = 0.f, s2 = 0.f;
#pragma unroll
            for (int i = 0; i < 16; ++i) { const f32x2 p = rowstat[(size_t)(t0 + tid) * 16 + i]; s1 += p[0]; s2 += p[1]; }
            const float mu = s1 * (1.f / GW), var = s2 * (1.f / GW) - mu * mu; st_mu[tid] = mu; st_rs[tid] = rsqrtf(var + EPS); }
        __syncthreads();
        build_transposed(vT, gv + (size_t)t0 * GW + g * 128, GW, tid, [&](float x, int s, int d) { return (x - st_mu[s]) * st_rs[s] * lng[d] + lnb[d]; });
        __syncthreads();
        f32x4 acc[8];
#pragma unroll
        for (int db = 0; db < 8; ++db) acc[db] = (f32x4){0.f, 0.f, 0.f, 0.f};
        const int nks = ((16 * w + 15) >> 5) + 1;
        for (int ks = 0; ks < nks; ++ks) {
            const bf16x8 bw = *(const LAS bf16x8*)(Wb + (16 * w + l15) * TP + (32 * ks + 8 * g4) * 2);
#pragma unroll
            for (int db = 0; db < 8; ++db) { const bf16x8 av = *(const LAS bf16x8*)(vT + (16 * db + l15) * TP + (32 * ks + 8 * g4) * 2); acc[db] = mfma16(av, bw, acc[db]); }
        }
        const int tl = 16 * w + l15; const float bias = a.in[6][g * 128 + tl];
        const size_t rowoff = (size_t)(t0 + tl);
#pragma unroll
        for (int db = 0; db < 8; ++db) { const int d = 16 * db + 4 * g4; const u32x2 uu = *(const u32x2*)(gu + rowoff * GW + g * 128 + d);
            u32x2 o; o.x = cvt_pk_bf16(bf_lo(uu.x) * (acc[db][0] + bias), bf_hi(uu.x) * (acc[db][1] + bias)); o.y = cvt_pk_bf16(bf_lo(uu.y) * (acc[db][2] + bias), bf_hi(uu.y) * (acc[db][3] + bias));
            *(u32x2*)(yab + rowoff * 2048 + g * 128 + d) = o; }
    }
    __syncthreads();
}
constexpr int H_A = 0, H_T1 = 128 * AP  , H_T2 = H_T1 + 128 * TP  , H_TOT = H_T2 + 128 * TP  ;

__device__ __forceinline__ void hgrn_load_scan(LAS unsigned char* A, LAS float* tot, const float* lf, int tid) {
#pragma unroll
    for (int it = 0; it < 8; ++it) { const int s = (tid >> 5) + 16 * it, col = (tid & 31) * 4; *(LAS f32x4*)(A + s * AP + col * 4) = *(const f32x4*)(lf + (size_t)s * GW + col); }
    __syncthreads();
    const int k = tid & 127, seg = tid >> 7;
    LAS float* colp = (LAS float*)(A + (32 * seg) * AP) + k;
    float run = 0.f;
#pragma unroll 8
    for (int r = 0; r < 32; ++r) { run += colp[r * (AP / 4)]; colp[r * (AP / 4)] = run; }
    tot[seg * 128 + k] = run;
    __syncthreads();
    float off = 0.f;
#pragma unroll
    for (int s2 = 0; s2 < 3; ++s2) if (s2 < seg) off += tot[s2 * 128 + k];
    if (seg > 0) {
#pragma unroll 8
        for (int r = 0; r < 32; ++r) colp[r * (AP / 4)] += off; }
    __syncthreads();
}

__device__ __forceinline__ void hgrn_h1_phase(Frame& F) {
    unsigned char* ws = F.ws;
    LAS unsigned char* A = F.lds + H_A; LAS unsigned char* kdT = F.lds + H_T1; LAS unsigned char* iT = F.lds + H_T2; LAS float* tot = (LAS float*)(F.lds + H_TOT);
    const int tid = F.tid, lane = F.lane, w = F.wave, g4 = lane >> 4, l15 = lane & 15;
    const float* lf = (const float*)(ws + WS_LF); const bf16_t* ib = (const bf16_t*)(ws + WS_IB);
    float* Hbuf = (float*)(ws + WS_HBUF); float* Dc = (float*)(ws + WS_DC);
    for (int u = F.bid; u < 1024; u += F.G) {
        const int c = u >> 3, h = u & 7, t0 = c * 128;
        __syncthreads();
        hgrn_load_scan(A, tot, lf + (size_t)t0 * GW + h * 128, tid);
#pragma unroll
        for (int it = 0; it < 2; ++it) {
            const int bi = tid + 512 * it, sb = bi >> 5, k0 = 4 * (bi & 31), s0 = 4 * sb;
            const f32x4 aend = *(const LAS f32x4*)(A + 127 * AP + k0 * 4);
            f32x4 prev = (f32x4){0.f, 0.f, 0.f, 0.f}; if (s0 > 0) prev = *(const LAS f32x4*)(A + (s0 - 1) * AP + k0 * 4);
            float v[4][4];
#pragma unroll
            for (int q = 0; q < 4; ++q) { const f32x4 cur = *(const LAS f32x4*)(A + (s0 + q) * AP + k0 * 4);
#pragma unroll
                for (int i = 0; i < 4; ++i) v[q][i] = (1.f - fast_exp(cur[i] - prev[i])) * fast_exp(aend[i] - cur[i]);
                prev = cur; }
#pragma unroll
            for (int i = 0; i < 4; ++i) { u32x2 o; o.x = cvt_pk_bf16(v[0][i], v[1][i]); o.y = cvt_pk_bf16(v[2][i], v[3][i]); *(LAS u32x2*)(kdT + (k0 + i) * TP + s0 * 2) = o; }
        }
        build_transposed(iT, ib + (size_t)t0 * GW + h * 128, GW, tid, [](float x, int, int) { return x; });
        if (tid < 128) Dc[(size_t)(c * 8 + h) * 128 + tid] = fast_exp(*(const LAS float*)(A + 127 * AP + tid * 4));
        __syncthreads();
        f32x4 acc[8];
#pragma unroll
        for (int kb = 0; kb < 8; ++kb) acc[kb] = (f32x4){0.f, 0.f, 0.f, 0.f};
#pragma unroll
        for (int ks = 0; ks < 4; ++ks) { const bf16x8 ai = *(const LAS bf16x8*)(iT + (16 * w + l15) * TP + (32 * ks + 8 * g4) * 2);
#pragma unroll
            for (int kb = 0; kb < 8; ++kb) { const bf16x8 bk = *(const LAS bf16x8*)(kdT + (16 * kb + l15) * TP + (32 * ks + 8 * g4) * 2); acc[kb] = mfma16(ai, bk, acc[kb]); } }
        float* hb = Hbuf + ((size_t)(c * 8 + h) * 128 + 16 * w + 4 * g4) * 128 + l15;
#pragma unroll
        for (int kb = 0; kb < 8; ++kb)
#pragma unroll
            for (int r = 0; r < 4; ++r) hb[r * 128 + 16 * kb] = acc[kb][r];
    }
    __syncthreads();
}

__device__ __forceinline__ void hgrn_h2_phase(Frame& F) {
    unsigned char* ws = F.ws;
    const float* __restrict__ Hbuf = (const float*)(ws + WS_HBUF); const float* __restrict__ Dc = (const float*)(ws + WS_DC); bf16_t* __restrict__ Sbuf = (bf16_t*)(ws + WS_SBUF);
    if (F.tid < 256) for (int p = F.bid * 256 + F.tid; p < 8 * 128 * 64; p += F.G * 256) {
        const int e = 2 * p, h = e >> 14, vk = e & 16383, k = e & 127;
        const float* hp = Hbuf + (size_t)h * 16384 + vk; bf16_t* sp = Sbuf + (size_t)h * 16384 + vk; const float* dp = Dc + h * 128 + k;
        f32x2 S = (f32x2){0.f, 0.f};
#pragma unroll 16
        for (int c = 0; c < 128; ++c) { *(unsigned*)(sp + (size_t)c * 131072) = cvt_pk_bf16(S[0], S[1]); const f32x2 d = *(const f32x2*)(dp + c * 1024), hv = *(const f32x2*)(hp + (size_t)c * 131072); S = d * S + hv; }
    }
}

__device__ __forceinline__ void hgrn_h3_phase(Frame& F) {
    const Args& a_ = *F.a; unsigned char* ws = F.ws;
    LAS unsigned char* A = F.lds + H_A;
    LAS unsigned char* iT = F.lds + H_T1; LAS unsigned char* ST = F.lds + H_T2; LAS float* tot = (LAS float*)(F.lds + H_TOT);
    LAS float* Gt = (LAS float*)(F.lds + H_TOT + 2048);
    const int tid = F.tid, lane = F.lane, w = F.wave, g4 = lane >> 4, l15 = lane & 15;
    const float* lf = (const float*)(ws + WS_LF); const bf16_t* ib = (const bf16_t*)(ws + WS_IB); const bf16_t* qb = (const bf16_t*)(ws + WS_QB); const bf16_t* sg = (const bf16_t*)(ws + WS_SG);
    const bf16_t* Sbuf = (const bf16_t*)(ws + WS_SBUF); bf16_t* yab = (bf16_t*)(ws + WS_YAB); const float* ng = a_.in[8];
    const f32x4 z4 = (f32x4){0.f, 0.f, 0.f, 0.f};
    for (int u = F.bid; u < 1024; u += F.G) {
        const int c = u >> 3, h = u & 7, t0 = c * 128;
        const int a = w, t = 16 * a + l15;
        __syncthreads();
        hgrn_load_scan(A, tot, lf + (size_t)t0 * GW + h * 128, tid);
        build_transposed(iT, ib + (size_t)t0 * GW + h * 128, GW, tid, [](float x, int, int) { return x; });
#pragma unroll
        for (int it = 0; it < 4; ++it) { const int ci = tid + 512 * it, v = ci >> 4, ch = ci & 15; *(LAS u32x4*)(ST + v * TP + ch * 16) = *(const u32x4*)(Sbuf + ((size_t)(c * 8 + h) * 128 + v) * 128 + ch * 8); }
        u32x4 kdv[4];
        { const int s_ = tid >> 2, kb = 32 * (tid & 3), se = (s_ | 15);
#pragma unroll
          for (int c8 = 0; c8 < 4; ++c8) { const int k0 = kb + 8 * c8;
              const f32x4 c0 = *(const LAS f32x4*)(A + s_ * AP + k0 * 4), c1 = *(const LAS f32x4*)(A + s_ * AP + k0 * 4 + 16);
              f32x4 p0 = z4, p1 = z4; if (s_ > 0) { p0 = *(const LAS f32x4*)(A + (s_ - 1) * AP + k0 * 4); p1 = *(const LAS f32x4*)(A + (s_ - 1) * AP + k0 * 4 + 16); }
              const f32x4 e0 = *(const LAS f32x4*)(A + se * AP + k0 * 4), e1 = *(const LAS f32x4*)(A + se * AP + k0 * 4 + 16);
              float kv[8];
#pragma unroll
              for (int j = 0; j < 4; ++j) { kv[j] = (1.f - fast_exp(c0[j] - p0[j])) * fast_exp(e0[j] - c0[j]); kv[4 + j] = (1.f - fast_exp(c1[j] - p1[j])) * fast_exp(e1[j] - c1[j]); }
              kdv[c8].x = cvt_pk_bf16(kv[0], kv[1]); kdv[c8].y = cvt_pk_bf16(kv[2], kv[3]); kdv[c8].z = cvt_pk_bf16(kv[4], kv[5]); kdv[c8].w = cvt_pk_bf16(kv[6], kv[7]); } }
        float gv[2];
#pragma unroll
        for (int r = 0; r < 2; ++r) { const int idx = tid + 512 * r, j = idx >> 7, k = idx & 127; const float hi = *(const LAS float*)(A + (16 * j + 15) * AP + k * 4); const float lo = j > 0 ? *(const LAS float*)(A + (16 * j - 1) * AP + k * 4) : 0.f; gv[r] = fast_exp(hi - lo); }
        bf16x8 qd[4]; float qh[4][8];
#pragma unroll
        for (int ks = 0; ks < 4; ++ks) { const int k0 = 32 * ks + 8 * g4; const u32x4 qr = *(const u32x4*)(qb + (size_t)(t0 + t) * GW + h * 128 + k0);
            const f32x4 A0 = *(const LAS f32x4*)(A + t * AP + k0 * 4), A1 = *(const LAS f32x4*)(A + t * AP + k0 * 4 + 16);
            const f32x4 E0 = *(const LAS f32x4*)(A + (16 * a + 15) * AP + k0 * 4), E1 = *(const LAS f32x4*)(A + (16 * a + 15) * AP + k0 * 4 + 16);
            const float qv[8] = {bf_lo(qr.x), bf_hi(qr.x), bf_lo(qr.y), bf_hi(qr.y), bf_lo(qr.z), bf_hi(qr.z), bf_lo(qr.w), bf_hi(qr.w)};
            float d[8];
#pragma unroll
            for (int j = 0; j < 4; ++j) { d[j] = qv[j] * fast_exp(A0[j]); d[4 + j] = qv[4 + j] * fast_exp(A1[j]); qh[ks][j] = qv[j] * fast_exp(A0[j] - E0[j]); qh[ks][4 + j] = qv[4 + j] * fast_exp(A1[j] - E1[j]); }
            u32x4 pd; pd.x = cvt_pk_bf16_m(d[0], d[1]); pd.y = cvt_pk_bf16_m(d[2], d[3]); pd.z = cvt_pk_bf16_m(d[4], d[5]); pd.w = cvt_pk_bf16_m(d[6], d[7]);
            qd[ks] = __builtin_bit_cast(bf16x8, pd); }
        __syncthreads();
        { const int s_ = tid >> 2, kb = 32 * (tid & 3);
#pragma unroll
          for (int c8 = 0; c8 < 4; ++c8) *(LAS u32x4*)(A + s_ * TP + (kb + 8 * c8) * 2) = kdv[c8];
#pragma unroll
          for (int r = 0; r < 2; ++r) Gt[tid + 512 * r] = gv[r]; }
        __syncthreads();
        f32x4 acc[8];
#pragma unroll
        for (int vb = 0; vb < 8; ++vb) acc[vb] = z4;
#pragma unroll
        for (int ks = 0; ks < 4; ++ks)
#pragma unroll
            for (int vb = 0; vb < 8; ++vb) { const bf16x8 as = *(const LAS bf16x8*)(ST + (16 * vb + l15) * TP + (32 * ks + 8 * g4) * 2); acc[vb] = mfma16(as, qd[ks], acc[vb]); }
        for (int bp = a; bp >= 0; bp -= 2) {
            u32x2 pk[2]; pk[0] = (u32x2){0u, 0u}; pk[1] = (u32x2){0u, 0u};
#pragma unroll
            for (int half = 0; half < 2; ++half) { const int b = bp - half;
                if (b >= 0) {
                    f32x4 pt = z4;
#pragma unroll
                    for (int ks = 0; ks < 4; ++ks) { const int k0 = 32 * ks + 8 * g4;
                        u32x4 qq; qq.x = cvt_pk_bf16_m(qh[ks][0], qh[ks][1]); qq.y = cvt_pk_bf16_m(qh[ks][2], qh[ks][3]); qq.z = cvt_pk_bf16_m(qh[ks][4], qh[ks][5]); qq.w = cvt_pk_bf16_m(qh[ks][6], qh[ks][7]);
                        const bf16x8 kd = *(const LAS bf16x8*)(A + (16 * b + l15) * TP + k0 * 2);
                        pt = mfma16(kd, __builtin_bit_cast(bf16x8, qq), pt);
                        const f32x4 G0 = *(const LAS f32x4*)(Gt + b * 128 + k0), G1 = *(const LAS f32x4*)(Gt + b * 128 + k0 + 4);
#pragma unroll
                        for (int j = 0; j < 4; ++j) { qh[ks][j] *= G0[j]; qh[ks][4 + j] *= G1[j]; } }
                    if (b == a) {
#pragma unroll
                        for (int r = 0; r < 4; ++r) if (4 * g4 + r > l15) pt[r] = 0.f; }
                    pk[half].x = cvt_pk_bf16_d(pt[0], pt[1]); pk[half].y = cvt_pk_bf16_m(pt[2], pt[3]);
                }
            }
            const int b1 = (bp - 1 >= 0) ? bp - 1 : bp;
            u32x4 bp4; bp4.x = pk[0].x; bp4.y = pk[0].y; bp4.z = pk[1].x; bp4.w = pk[1].y;
            const bf16x8 bP = __builtin_bit_cast(bf16x8, bp4);
#pragma unroll
            for (int vb = 0; vb < 8; ++vb) { const u32x2 lo = *(const LAS u32x2*)(iT + (16 * vb + l15) * TP + (16 * bp + 4 * g4) * 2), hi = *(const LAS u32x2*)(iT + (16 * vb + l15) * TP + (16 * b1 + 4 * g4) * 2);
                u32x4 ai; ai.x = lo.x; ai.y = lo.y; ai.z = hi.x; ai.w = hi.y; acc[vb] = mfma16(__builtin_bit_cast(bf16x8, ai), bP, acc[vb]); }
        }
        float ssq = 0.f;
#pragma unroll
        for (int vb = 0; vb < 8; ++vb) ssq += (acc[vb][0] * acc[vb][0] + acc[vb][1] * acc[vb][1]) + (acc[vb][2] * acc[vb][2] + acc[vb][3] * acc[vb][3]);
        ssq += __shfl_xor(ssq, 16); ssq += __shfl_xor(ssq, 32);
        const float rstd = rsqrtf(ssq * (1.f / 128.f) + EPS);
#pragma unroll
        for (int vb = 0; vb < 8; ++vb) { const int v = 16 * vb + 4 * g4; const f32x4 g4v = *(const f32x4*)(ng + h * 128 + v); const u32x2 sv = *(const u32x2*)(sg + (size_t)(t0 + t) * GW + h * 128 + v);
            u32x2 o; o.x = cvt_pk_bf16(acc[vb][0] * rstd * g4v[0] * bf_lo(sv.x), acc[vb][1] * rstd * g4v[1] * bf_hi(sv.x)); o.y = cvt_pk_bf16(acc[vb][2] * rstd * g4v[2] * bf_lo(sv.y), acc[vb][3] * rstd * g4v[3] * bf_hi(sv.y));
            *(u32x2*)(yab + (size_t)(t0 + t) * 2048 + 1024 + h * 128 + v) = o; }
    }
    __syncthreads();
}
__device__ __forceinline__ void build_router_weights(Frame& F) {
    const Args& a = *F.a; bf16_t* wrt = (bf16_t*)(F.ws + WS_WRT);
    for (int i = F.bid * NTHR + F.tid; i < 80 * 256; i += F.G * NTHR) {
        const int n = i >> 8, k0 = (i & 255) * 8; float v[8];
#pragma unroll
        for (int j = 0; j < 8; ++j) v[j] = n < 8 ? a.in[13][(size_t)(k0 + j) * 8 + n] : n < 72 ? a.in[15][(size_t)(k0 + j) * 64 + (n - 8)] : 0.f;
        u32x4 hi, lo;
#pragma unroll
        for (int q = 0; q < 4; ++q) { const unsigned h = cvt_pk_bf16(v[2 * q], v[2 * q + 1]); hi[q] = h; lo[q] = cvt_pk_bf16(v[2 * q] - bf_lo(h), v[2 * q + 1] - bf_hi(h)); }
        *(u32x4*)(wrt + (size_t)n * D + k0) = hi; *(u32x4*)(wrt + (size_t)(80 + n) * D + k0) = lo;
    }
}
__device__ __forceinline__ void route_phase(Frame& F) {
    const Args& a = *F.a; unsigned char* ws = F.ws;
    const bf16_t* x1 = (const bf16_t*)(ws + WS_YAB);   const float* g = a.in[12]; const float* brg = a.in[14]; const float* bre = a.in[16];
    const bf16_t* wrt = (const bf16_t*)(ws + WS_WRT);
    bf16_t* h2 = (bf16_t*)(ws + WS_H); int* counts = (int*)(ws + WS_CTL) + CW_COUNTS;
    LAS f32x4* slab = (LAS f32x4*)F.lds;
    LAS float* ltile = (LAS float*)(F.lds + 4 * 21 * 1024);
    const int lane = F.lane, w = F.wave, g4 = lane >> 4, l15 = lane & 15;
    for (int blk = F.bid; blk < T / 64; blk += F.G) {
        f32x4 acc[4][5]; f32x4 ssq = (f32x4){0.f, 0.f, 0.f, 0.f};
#pragma unroll
        for (int tt = 0; tt < 4; ++tt)
#pragma unroll
            for (int nb = 0; nb < 5; ++nb) acc[tt][nb] = (f32x4){0.f, 0.f, 0.f, 0.f};
        const bf16_t* xr = x1 + (size_t)(blk * 64 + l15) * D + w * 256 + 8 * g4; const float* gr = g + w * 256 + 8 * g4;
        unsigned char* hr = (unsigned char*)h2 + (size_t)(blk * 64 + l15) * D + w * 256 + 8 * g4; const bf16_t* wr = wrt + (size_t)l15 * D + w * 256 + 8 * g4;
#pragma unroll 2
        for (int ks = 0; ks < 8; ++ks) {
            const f32x4 g0 = *(const f32x4*)(gr + 32 * ks), g1 = *(const f32x4*)(gr + 32 * ks + 4);
            bf16x8 wh[5], wl[5];
#pragma unroll
            for (int nb = 0; nb < 5; ++nb) { wh[nb] = *(const bf16x8*)(wr + (size_t)(16 * nb) * D + 32 * ks); wl[nb] = *(const bf16x8*)(wr + (size_t)(80 + 16 * nb) * D + 32 * ks); }
#pragma unroll
            for (int tt = 0; tt < 4; ++tt) {
                const u32x4 xp = *(const u32x4*)(xr + (size_t)(16 * tt) * D + 32 * ks); const f32x4 x0 = (f32x4){bf_lo(xp.x), bf_hi(xp.x), bf_lo(xp.y), bf_hi(xp.y)}, x1v = (f32x4){bf_lo(xp.z), bf_hi(xp.z), bf_lo(xp.w), bf_hi(xp.w)};
                ssq[tt] += (x0[0] * x0[0] + x0[1] * x0[1]) + (x0[2] * x0[2] + x0[3] * x0[3]) + (x1v[0] * x1v[0] + x1v[1] * x1v[1]) + (x1v[2] * x1v[2] + x1v[3] * x1v[3]);
                const f32x4 y0 = x0 * g0, y1 = x1v * g1;
                u32x4 hi, lo;
                hi.x = cvt_pk_bf16_m(y0[0], y0[1]); hi.y = cvt_pk_bf16_m(y0[2], y0[3]); hi.z = cvt_pk_bf16_m(y1[0], y1[1]); hi.w = cvt_pk_bf16_m(y1[2], y1[3]);
                lo.x = cvt_pk_bf16_m(y0[0] - bf_lo(hi.x), y0[1] - bf_hi(hi.x)); lo.y = cvt_pk_bf16_m(y0[2] - bf_lo(hi.y), y0[3] - bf_hi(hi.y));
                lo.z = cvt_pk_bf16_m(y1[0] - bf_lo(hi.z), y1[1] - bf_hi(hi.z)); lo.w = cvt_pk_bf16_m(y1[2] - bf_lo(hi.w), y1[3] - bf_hi(hi.w));
                { u32x2 q8; q8.x = pk4_fp8(clamp448(y0[0]), clamp448(y0[1]), clamp448(y0[2]), clamp448(y0[3])); q8.y = pk4_fp8(clamp448(y1[0]), clamp448(y1[1]), clamp448(y1[2]), clamp448(y1[3])); *(u32x2*)(hr + (size_t)(16 * tt) * D + 32 * ks) = q8; }
                const bf16x8 bh = __builtin_bit_cast(bf16x8, hi), bl = __builtin_bit_cast(bf16x8, lo);
#pragma unroll
                for (int nb = 0; nb < 5; ++nb) { acc[tt][nb] = mfma16(wh[nb], bh, acc[tt][nb]); acc[tt][nb] = mfma16(wh[nb], bl, acc[tt][nb]); acc[tt][nb] = mfma16(wl[nb], bh, acc[tt][nb]); }
            }
        }
#pragma unroll
        for (int half = 4; half >= 1; half >>= 1) {
            __syncthreads();
            if (w >= half && w < 2 * half) { LAS f32x4* p = slab + (size_t)(w - half) * 21 * 64 + lane;
#pragma unroll
                for (int tt = 0; tt < 4; ++tt)
#pragma unroll
                    for (int nb = 0; nb < 5; ++nb) p[(tt * 5 + nb) * 64] = acc[tt][nb];
                p[20 * 64] = ssq; }
            __syncthreads();
            if (w < half) { const LAS f32x4* p = slab + (size_t)w * 21 * 64 + lane;
#pragma unroll
                for (int tt = 0; tt < 4; ++tt)
#pragma unroll
                    for (int nb = 0; nb < 5; ++nb) acc[tt][nb] += p[(tt * 5 + nb) * 64];
                ssq += p[20 * 64]; }
        }
        if (w == 0) {
#pragma unroll
            for (int tt = 0; tt < 4; ++tt) { float s = ssq[tt]; s += __shfl_xor(s, 16); s += __shfl_xor(s, 32);
                const float rs = rsqrtf(s * (1.f / D) + EPS);
                LAS float* lt = ltile + (tt * 16 + l15) * 84;
#pragma unroll
                for (int nb = 0; nb < 5; ++nb) *(LAS f32x4*)(lt + 16 * nb + 4 * g4) = acc[tt][nb] * rs;
                if (g4 == 0) lt[80] = rs; }
        }
        __syncthreads();
        LAS int* lcnt = (LAS int*)(ltile + 64 * 84); LAS int* lbase = lcnt + 64;
        if (w == 7) lcnt[lane] = 0;
        const bool tokthr = w < 4 && lane < 16;
        const int t = blk * 64 + w * 16 + lane;
        int ea = 0, eb = 0; float wa = 0.f, wb2 = 0.f, rsv = 0.f;
        if (tokthr) {
            const LAS float* lt = ltile + (w * 16 + lane) * 84;
            int gsel = 0; float gmax = lt[0] + brg[0]; float den = 0.f;
            for (int n = 1; n < 8; ++n) { const float v = lt[n] + brg[n]; if (v > gmax) { gmax = v; gsel = n; } }
            for (int n = 0; n < 8; ++n) den += expf(lt[n] + brg[n] - gmax);
            const float pg = 1.f / den;
            int i1 = 0; float v1 = lt[8 + gsel * 8] + bre[gsel * 8];
            for (int n = 1; n < 8; ++n) { const float v = lt[8 + gsel * 8 + n] + bre[gsel * 8 + n]; if (v > v1) { v1 = v; i1 = n; } }
            int i2 = 0; float v2 = -3.0e38f;
            for (int n = 0; n < 8; ++n) { const float v = lt[8 + gsel * 8 + n] + bre[gsel * 8 + n]; if (n != i1 && v > v2) { v2 = v; i2 = n; } }
            const float e2 = expf(v2 - v1); const float w1 = 1.f / (1.f + e2), w2 = e2 / (1.f + e2);
            ea = gsel * 8 + i1; eb = gsel * 8 + i2; wa = w1 * pg; wb2 = w2 * pg; rsv = lt[80];
        }
        __syncthreads();
        int ra = 0, rb = 0;
        if (tokthr) { ra = __hip_atomic_fetch_add(lcnt + ea, 1, __ATOMIC_RELAXED, __HIP_MEMORY_SCOPE_WORKGROUP); rb = __hip_atomic_fetch_add(lcnt + eb, 1, __ATOMIC_RELAXED, __HIP_MEMORY_SCOPE_WORKGROUP); }
        __syncthreads();
        if (w == 0) { const int c = lcnt[lane]; lbase[lane] = c ? atomicAdd(&counts[lane], c) : 0; }
        __syncthreads();
        if (tokthr) {
            const int pa = lbase[ea] + ra, pb = lbase[eb] + rb;
            int* ltok = (int*)(ws + WS_LTOK); float* lw = (float*)(ws + WS_LW); float* lrs = (float*)(ws + WS_LRS); int* slot_of = (int*)(ws + WS_SLOTOF);
            ltok[ea * T + pa] = t; lw[ea * T + pa] = wa; lrs[ea * T + pa] = rsv;
            ltok[eb * T + pb] = t; lw[eb * T + pb] = wb2; lrs[eb * T + pb] = rsv;
            slot_of[t * 2] = (ea << 16) | pa; slot_of[t * 2 + 1] = (eb << 16) | pb;
        }
    }
    __syncthreads();
}
__device__ __forceinline__ void moe_tile_table(Frame& F, LAS int* tstart) {
    const int* counts = (const int*)(F.ws + WS_CTL) + CW_COUNTS;
    __syncthreads();
    if (F.tid == 0) { int acc = 0; for (int e = 0; e < NE; ++e) { tstart[e] = acc; acc += (counts[e] + 255) >> 8; } tstart[NE] = acc; }
    __syncthreads();
}
__device__ __forceinline__ void assign_phase(Frame& F) {
    unsigned char* ws = F.ws;
    LAS int* tstart = (LAS int*)F.lds;
    moe_tile_table(F, tstart);
    const int* tok_e = (const int*)(ws + WS_TOKE); const float* tok_w = (const float*)(ws + WS_TOKW); int* cursor = (int*)(ws + WS_CTL) + CW_CURSOR;
    int* slot_of = (int*)(ws + WS_SLOTOF); float* slot_w = (float*)(ws + WS_SLOTW); float* slot_rs = (float*)(ws + WS_SLOTRS); const float* rstd2 = (const float*)(ws + WS_RSTD2);
    const bf16_t* h2 = (const bf16_t*)(ws + WS_H); bf16_t* xg = (bf16_t*)(ws + WS_XG);
    const int lane = F.lane, gw = F.bid * NWAVES + F.wave, NGW = F.G * NWAVES;
    for (int i = gw; i < 2 * T; i += NGW) {
        const int e = tok_e[i];
        int slot = 0;
        if (lane == 0) { slot = tstart[e] * 256 + atomicAdd(&cursor[e], 1); slot_of[i] = slot; slot_w[slot] = tok_w[i]; slot_rs[slot] = rstd2[i >> 1]; }
        slot = __shfl(slot, 0);
        const u32x4* src = (const u32x4*)(h2 + (size_t)(i >> 1) * D); u32x4* dst = (u32x4*)(xg + (size_t)slot * D);
#pragma unroll
        for (int j = 0; j < 4; ++j) dst[lane + 64 * j] = src[lane + 64 * j];
    }
}
struct MoeOrder {
    const char* A; const char* Bt; size_t a_tile, b_tile, b_expert; const LAS int* tstart; int per, xcd, rank, total;
    __device__ void init(const void* A_, const void* Bt_, int lda, int ldb, const LAS int* ts, int G, int c) {
        A = (const char*)A_; Bt = (const char*)Bt_; a_tile = (size_t)256 * lda * 2; b_tile = (size_t)256 * ldb * 2; b_expert = (size_t)2048 * ldb * 2; tstart = ts;
        per = G >> 3; xcd = c & 7; rank = c >> 3; total = ts[NE] * 8; }
    __device__ bool next(int i, pg8::Unit& u) const {
        const int L = (i * 8 + xcd) * per + rank; if (L >= total || rank >= per) return false;
        int e = 0; while (tstart[e + 1] * 8 <= L) ++e;
        const int t0 = tstart[e], nt = tstart[e + 1] - t0, r = L - t0 * 8, pn = r / nt, mt = r - pn * nt;
        u.pm = t0 + mt; u.pn = pn; u.aux = e; u.A = A + (size_t)u.pm * a_tile; u.B = Bt + (size_t)e * b_expert + (size_t)pn * b_tile; return true;
    }
};
struct EpiSwiglu {
    static constexpr bool PERM = true, HAS_MID = false;
    bf16_t* act; const float* slot_rs;
    __device__ __forceinline__ void mid(f32x4 (&)[2][2][4][2], const pg8::Unit&, int, int, int, int) const {}
    __device__ __forceinline__ void operator()(const f32x4 (&acc)[2][2][4][2], const pg8::Unit& u, int wr, int wc, int fr, int fq) const {
        const int row0 = u.pm * 256 + wr * 64 + fr, c0 = u.pn * 128 + wc * 32 + 8 * fq;
#pragma unroll
        for (int ai = 0; ai < 2; ++ai)
#pragma unroll
            for (int m = 0; m < 4; ++m) { const float rs = slot_rs[row0 + ai * 128 + m * 16]; const f32x4 g0 = acc[ai][0][m][0] * rs, g1 = acc[ai][0][m][1] * rs, u0 = acc[ai][1][m][0] * rs, u1 = acc[ai][1][m][1] * rs; float o[8];
#pragma unroll
                for (int j = 0; j < 4; ++j) { o[j] = g0[j] * fast_sigmoid(g0[j]) * u0[j]; o[4 + j] = g1[j] * fast_sigmoid(g1[j]) * u1[j]; }
                u32x4 w; w.x = cvt_pk_bf16(o[0], o[1]); w.y = cvt_pk_bf16(o[2], o[3]); w.z = cvt_pk_bf16(o[4], o[5]); w.w = cvt_pk_bf16(o[6], o[7]);
                *(u32x4*)(act + (size_t)(row0 + ai * 128 + m * 16) * DE + c0) = w; }
    }
};
struct EpiDown {
    static constexpr bool PERM = true, HAS_MID = false;
    bf16_t* yb; const float* slot_w;
    __device__ __forceinline__ void mid(f32x4 (&)[2][2][4][2], const pg8::Unit&, int, int, int, int) const {}
    __device__ __forceinline__ void operator()(const f32x4 (&acc)[2][2][4][2], const pg8::Unit& u, int wr, int wc, int fr, int fq) const {
        const int row0 = u.pm * 256 + wr * 64 + fr, c0 = u.pn * 256 + wc * 32 + 8 * fq;
#pragma unroll
        for (int ai = 0; ai < 2; ++ai)
#pragma unroll
            for (int m = 0; m < 4; ++m) { const int row = row0 + ai * 128 + m * 16; const float sw = slot_w[row];
#pragma unroll
                for (int bj = 0; bj < 2; ++bj) { const f32x4 v0 = acc[ai][bj][m][0] * sw, v1 = acc[ai][bj][m][1] * sw;
                    u32x4 w; w.x = cvt_pk_bf16(v0[0], v0[1]); w.y = cvt_pk_bf16(v0[2], v0[3]); w.z = cvt_pk_bf16(v1[0], v1[1]); w.w = cvt_pk_bf16(v1[2], v1[3]);
                    *(u32x4*)(yb + (size_t)row * D + c0 + bj * 128) = w; } }
    }
};
__device__ __forceinline__ void moe_tile_table128(Frame& F, LAS int* tstart);
#define F8(w, i) __builtin_amdgcn_cvt_f32_fp8((w), (i))
__device__ __forceinline__ void final_phase(Frame& F) {
    const Args& a = *F.a; unsigned char* ws = F.ws;
    const int* slot_of = (const int*)(ws + WS_SLOTOF); const unsigned char* yb = ws + WS_YB;   const float* g = a.in[20]; float* out = a.out; const bf16_t* x1b = (const bf16_t*)(ws + WS_YAB);
    LAS int* tstart = (LAS int*)F.lds; moe_tile_table128(F, tstart);
    const int lane = F.lane, gw = F.bid * NWAVES + F.wave, NGW = F.G * NWAVES;
    for (int row = gw; row < T; row += 2 * NGW) {
        const int rowb = row + NGW < T ? row + NGW : row;
        const int k0 = slot_of[row * 2], k1 = slot_of[row * 2 + 1], k2 = slot_of[rowb * 2], k3 = slot_of[rowb * 2 + 1];
        const int s0 = tstart[k0 >> 16] * 128 + (k0 & 0xffff), s1 = tstart[k1 >> 16] * 128 + (k1 & 0xffff), s2 = tstart[k2 >> 16] * 128 + (k2 & 0xffff), s3 = tstart[k3 >> 16] * 128 + (k3 & 0xffff);
        f32x4* xa = (f32x4*)(out + (size_t)row * D); f32x4* xb = (f32x4*)(out + (size_t)rowb * D);
        const u32x2* xqa = (const u32x2*)(x1b + (size_t)row * D); const u32x2* xqb = (const u32x2*)(x1b + (size_t)rowb * D);
        const unsigned* y0 = (const unsigned*)(yb + (size_t)s0 * D); const unsigned* y1 = (const unsigned*)(yb + (size_t)s1 * D);
        const unsigned* y2 = (const unsigned*)(yb + (size_t)s2 * D); const unsigned* y3 = (const unsigned*)(yb + (size_t)s3 * D);
        f32x4 va[8], vb[8]; float sa = 0.f, sb = 0.f;
#pragma unroll
        for (int j = 0; j < 8; ++j) { const u32x2 xq = xqa[lane + 64 * j]; const f32x4 x = (f32x4){bf_lo(xq.x), bf_hi(xq.x), bf_lo(xq.y), bf_hi(xq.y)}; const int p = (int)y0[lane + 64 * j], q = (int)y1[lane + 64 * j];
            va[j] = (f32x4){x[0] + (F8(p, 0) + F8(q, 0)) * 0.0625f, x[1] + (F8(p, 1) + F8(q, 1)) * 0.0625f, x[2] + (F8(p, 2) + F8(q, 2)) * 0.0625f, x[3] + (F8(p, 3) + F8(q, 3)) * 0.0625f};
            sa += (va[j][0] * va[j][0] + va[j][1] * va[j][1]) + (va[j][2] * va[j][2] + va[j][3] * va[j][3]); }
#pragma unroll
        for (int j = 0; j < 8; ++j) { const u32x2 xq = xqb[lane + 64 * j]; const f32x4 x = (f32x4){bf_lo(xq.x), bf_hi(xq.x), bf_lo(xq.y), bf_hi(xq.y)}; const int p = (int)y2[lane + 64 * j], q = (int)y3[lane + 64 * j];
            vb[j] = (f32x4){x[0] + (F8(p, 0) + F8(q, 0)) * 0.0625f, x[1] + (F8(p, 1) + F8(q, 1)) * 0.0625f, x[2] + (F8(p, 2) + F8(q, 2)) * 0.0625f, x[3] + (F8(p, 3) + F8(q, 3)) * 0.0625f};
            sb += (vb[j][0] * vb[j][0] + vb[j][1] * vb[j][1]) + (vb[j][2] * vb[j][2] + vb[j][3] * vb[j][3]); }
        const float ra = rsqrtf(wave_sum(sa) * (1.f / D) + EPS), rb = rsqrtf(wave_sum(sb) * (1.f / D) + EPS);
#pragma unroll
        for (int j = 0; j < 8; ++j) { const f32x4 gg = ((const f32x4*)g)[lane + 64 * j]; xa[lane + 64 * j] = va[j] * ra * gg; if (rowb != row) xb[lane + 64 * j] = vb[j] * rb * gg; }
    }
}
namespace mg {
constexpr int BPITCH = 144, A_BYTES = 16384, STG = A_BYTES + 256 * BPITCH  ;
__device__ __forceinline__ int inv_perm32(int c) { return ((c >> 2) & 1) * 16 + ((c >> 3) << 2) + (c & 3); }
struct Unit { const float* B0; const float* B1; int pm, pn, e; };
struct Order {
    const LAS int* tstart; int per, xcd, rank, total; const float* W0; const float* W1; size_t wexp; int up;
    __device__ void init(const LAS int* ts, int G, int c, const float* W0_, const float* W1_, size_t wexp_, int up_) { tstart = ts; per = G >> 3; xcd = c & 7; rank = c >> 3; total = ts[NE] * 8; W0 = W0_; W1 = W1_; wexp = wexp_; up = up_; }
    __device__ bool next(int i, Unit& u) const {
        const int L = (i * 8 + xcd) * per + rank; if (L >= total || rank >= per) return false;
        int e = 0; while (tstart[e + 1] * 8 <= L) ++e;
        const int t0 = tstart[e], nt = tstart[e + 1] - t0, r = L - t0 * 8, pn = r / nt, mt = r - pn * nt;
        u.pm = t0 + mt; u.pn = pn; u.e = e;
        if (up) { u.B0 = W0 + (size_t)e * wexp + pn * 128; u.B1 = W1 + (size_t)e * wexp + pn * 128; }
        else { u.B0 = W0 + (size_t)e * wexp + pn * 256; u.B1 = u.B0 + 128; }
        return true;
    }
};
template <class Epi, bool GATHER>
__device__ __forceinline__ void gemm(LAS unsigned char* lds, const bf16_t* Abase, int lda, const int* row_idx, int K, int ldb, const Order& S, const Epi& E) {
    const int tid = threadIdx.x, wid = __builtin_amdgcn_readfirstlane(tid >> 6), lane = tid & 63, wr = wid >> 2, wc = wid & 3, fr = lane & 15, fq = lane >> 4;
    const int nt = K / 64;
    int Rr[2], Cc[2];
#pragma unroll
    for (int i = 0; i < 2; ++i) pg8::stage_rc(tid * 16 + i * 8192, Rr[i], Cc[i]);
    const unsigned ldsw = (unsigned)wid * 1024u;
    const int aoff = pg8::lds_byte(wr * 64 + fr, fq * 8), boff = A_BYTES + (wc * 32 + fr) * BPITCH + fq * 16;
    unsigned wrow[2][2];
#pragma unroll
    for (int h = 0; h < 2; ++h)
#pragma unroll
        for (int j = 0; j < 2; ++j) { const int n = 2 * lane + j; wrow[h][j] = (unsigned)(A_BYTES + (h * 128 + (n & ~31) + inv_perm32(n & 31)) * BPITCH + 16 * wid); }
#define MG_DMA_A(stage, t) do { _Pragma("unroll") for (int _i = 0; _i < 2; ++_i) \
        __builtin_amdgcn_global_load_lds((const unsigned*)((const char*)Abase + voffA[_i] + (size_t)(t) * 128), (LAS unsigned*)(lds + (stage) * STG + ldsw + _i * 8192), 16, 0, 0); } while (0)
#define MG_LOADB(set, t) do { const unsigned _vo = (unsigned)(2 * lane) * 4u; const size_t _kr = (size_t)(64 * (t) + 8 * wid) * ldb; _Pragma("unroll") for (int _i = 0; _i < 8; ++_i) { \
        asm volatile("global_load_dwordx2 %0, %1, %2" : "=v"(set[0][_i]) : "v"(_vo), "s"(u.B0 + _kr + (size_t)_i * ldb) : "memory"); asm volatile("global_load_dwordx2 %0, %1, %2" : "=v"(set[1][_i]) : "v"(_vo), "s"(u.B1 + _kr + (size_t)_i * ldb) : "memory"); } } while (0)
#define MG_CVTW(set, stage) do { _Pragma("unroll") for (int _h = 0; _h < 2; ++_h) _Pragma("unroll") for (int _j = 0; _j < 2; ++_j) { u32x4 _w; \
        _w.x = cvt_pk_bf16(set[_h][0][_j], set[_h][1][_j]); _w.y = cvt_pk_bf16(set[_h][2][_j], set[_h][3][_j]); _w.z = cvt_pk_bf16(set[_h][4][_j], set[_h][5][_j]); _w.w = cvt_pk_bf16(set[_h][6][_j], set[_h][7][_j]); \
        *(LAS u32x4*)(lds + (stage) * STG + wrow[_h][_j]) = _w; } } while (0)
#define MG_LDFRAG(stage) do { _Pragma("unroll") for (int n = 0; n < 2; ++n) _Pragma("unroll") for (int k = 0; k < 2; ++k) { \
        B0[n][k] = *(const LAS bf16x8*)(lds + (stage) * STG + boff + (n * 16) * BPITCH + k * 64); B1[n][k] = *(const LAS bf16x8*)(lds + (stage) * STG + boff + (128 + n * 16) * BPITCH + k * 64); } \
        _Pragma("unroll") for (int m = 0; m < 4; ++m) _Pragma("unroll") for (int k = 0; k < 2; ++k) At[m][k] = *(const LAS bf16x8*)(lds + (stage) * STG + aoff + m * 2048 + k * 1024); } while (0)
#define MG_MMA() do { __builtin_amdgcn_s_setprio(1); _Pragma("unroll") for (int m = 0; m < 4; ++m) _Pragma("unroll") for (int n = 0; n < 2; ++n) _Pragma("unroll") for (int k = 0; k < 2; ++k) { \
        acc[0][m][n] = __builtin_amdgcn_mfma_f32_16x16x32_bf16(B0[n][k], At[m][k], acc[0][m][n], 0, 0, 0); acc[1][m][n] = __builtin_amdgcn_mfma_f32_16x16x32_bf16(B1[n][k], At[m][k], acc[1][m][n], 0, 0, 0); } __builtin_amdgcn_s_setprio(0); } while (0)
#define MG_W1() do { asm volatile("s_waitcnt vmcnt(16)" ::: "memory"); asm volatile("s_waitcnt lgkmcnt(0)" ::: "memory"); __builtin_amdgcn_s_barrier(); asm volatile("" ::: "memory"); } while (0)
    Unit u;
    for (int ui = 0; S.next(ui, u); ++ui) {
        unsigned voffA[2];
#pragma unroll
        for (int i = 0; i < 2; ++i) { const int slot = u.pm * 128 + Rr[i]; const int idx = GATHER ? row_idx[slot] : slot; voffA[i] = (unsigned)(idx * lda + Cc[i]) * 2u; }
        f32x4 acc[2][4][2];
#pragma unroll
        for (int b = 0; b < 2; ++b)
#pragma unroll
            for (int m = 0; m < 4; ++m)
#pragma unroll
                for (int n = 0; n < 2; ++n) acc[b][m][n] = (f32x4){0.f, 0.f, 0.f, 0.f};
        bf16x8 At[4][2], B0[2][2], B1[2][2];
        f32x2 sa[2][8], sb[2][8];
        MG_DMA_A(0, 0);
        MG_LOADB(sa, 0); MG_LOADB(sb, 1);
        asm volatile("s_waitcnt vmcnt(16)" ::: "memory");
        MG_CVTW(sa, 0);
        MG_LOADB(sa, 2);
        for (int t = 0; t < nt; t += 2) {
            const int t1 = t + 1 < nt ? t + 1 : nt - 1, t2 = t + 2 < nt ? t + 2 : nt - 1, t3 = t + 3 < nt ? t + 3 : nt - 1, t4 = t + 4 < nt ? t + 4 : nt - 1;
            MG_W1();
            MG_LDFRAG(0);
            MG_CVTW(sb, 1);
            MG_DMA_A(1, t1); MG_LOADB(sb, t3);
            asm volatile("s_waitcnt lgkmcnt(0)" ::: "memory");
            MG_MMA();
            MG_W1();
            MG_LDFRAG(1);
            MG_CVTW(sa, 0);
            MG_DMA_A(0, t2); MG_LOADB(sa, t4);
            asm volatile("s_waitcnt lgkmcnt(0)" ::: "memory");
            MG_MMA();
        }
        asm volatile("s_waitcnt vmcnt(0)" ::: "memory"); asm volatile("s_waitcnt lgkmcnt(0)" ::: "memory"); __builtin_amdgcn_s_barrier(); asm volatile("" ::: "memory");
        E(acc, u, wr, wc, fr, fq);
    }
#undef MG_DMA_A
#undef MG_LOADB
#undef MG_CVTW
#undef MG_LDFRAG
#undef MG_MMA
#undef MG_W1
}
}

__device__ __forceinline__ void moe_tile_table128(Frame& F, LAS int* tstart) {
    const int* counts = (const int*)(F.ws + WS_CTL) + CW_COUNTS;
    __syncthreads();
    if (F.tid < NE) { const int n = (counts[F.tid] + 127) >> 7; int incl = n;
#pragma unroll
        for (int d = 1; d < 64; d <<= 1) { const int v = __shfl_up(incl, d); if (F.tid >= d) incl += v; }
        tstart[F.tid] = incl - n; if (F.tid == NE - 1) tstart[NE] = incl; }
    __syncthreads();
    if (F.tid < NE) { const int e = F.tid, ne = tstart[e + 1] - tstart[e]; int j = 0;
        for (int o = 0; o < NE; ++o) { const int no = tstart[o + 1] - tstart[o]; j += (no > ne || (no == ne && o < e)) ? 1 : 0; }
        const int pos = j < 16 ? j : j < 32 ? 16 + (31 - j) : j < 48 ? 32 + (j - 32) : 48 + (63 - j);
        tstart[80 + pos] = e; }
    __syncthreads();
}
__device__ __forceinline__ void assign_phase2(Frame& F) {
    unsigned char* ws = F.ws;
    LAS int* tstart = (LAS int*)F.lds;
    moe_tile_table128(F, tstart);
    const int* tok_e = (const int*)(ws + WS_TOKE); const float* tok_w = (const float*)(ws + WS_TOKW); int* cursor = (int*)(ws + WS_CTL) + CW_CURSOR; const int* counts = (const int*)(ws + WS_CTL) + CW_COUNTS;
    int* slot_of = (int*)(ws + WS_SLOTOF); float* slot_w = (float*)(ws + WS_SLOTW); float* slot_rs = (float*)(ws + WS_SLOTRS); const float* rstd2 = (const float*)(ws + WS_RSTD2); int* row_idx = (int*)(ws + WS_ROWIDX);
    if (F.bid == 0 && F.tid < NE) { const int e = F.tid, base = tstart[e] * 128, end = tstart[e + 1] * 128;
        for (int s = base + counts[e]; s < end; ++s) { row_idx[s] = 0; slot_w[s] = 0.f; slot_rs[s] = 1.f; } }
    for (int i = F.bid * NTHR + F.tid; i < 2 * T; i += F.G * NTHR) {
        const int e = tok_e[i]; const int slot = tstart[e] * 128 + atomicAdd(&cursor[e], 1);
        slot_of[i] = slot; row_idx[slot] = i >> 1; slot_w[slot] = tok_w[i]; slot_rs[slot] = rstd2[i >> 1];
    }
}
struct EpiSwiglu128 {
    bf16_t* act; const float* slot_rs;
    __device__ __forceinline__ void operator()(const f32x4 (&acc)[2][4][2], const mg::Unit& u, int wr, int wc, int fr, int fq) const {
        const int row0 = u.pm * 128 + wr * 64 + fr, c0 = u.pn * 128 + wc * 32 + 8 * fq;
#pragma unroll
        for (int m = 0; m < 4; ++m) { const int row = row0 + m * 16; const float rs = slot_rs[row]; const f32x4 g0 = acc[0][m][0] * rs, g1 = acc[0][m][1] * rs, u0 = acc[1][m][0] * rs, u1 = acc[1][m][1] * rs; float o[8];
#pragma unroll
            for (int j = 0; j < 4; ++j) { o[j] = g0[j] * fast_sigmoid(g0[j]) * u0[j]; o[4 + j] = g1[j] * fast_sigmoid(g1[j]) * u1[j]; }
            u32x4 w; w.x = cvt_pk_bf16(o[0], o[1]); w.y = cvt_pk_bf16(o[2], o[3]); w.z = cvt_pk_bf16(o[4], o[5]); w.w = cvt_pk_bf16(o[6], o[7]);
            *(u32x4*)(act + (size_t)row * DE + c0) = w; }
    }
};
struct EpiDown128 {
    bf16_t* yb; const float* slot_w;
    __device__ __forceinline__ void operator()(const f32x4 (&acc)[2][4][2], const mg::Unit& u, int wr, int wc, int fr, int fq) const {
        const int row0 = u.pm * 128 + wr * 64 + fr, c0 = u.pn * 256 + wc * 32 + 8 * fq;
#pragma unroll
        for (int m = 0; m < 4; ++m) { const int row = row0 + m * 16; const float sw = slot_w[row];
#pragma unroll
            for (int bj = 0; bj < 2; ++bj) { const f32x4 v0 = acc[bj][m][0] * sw, v1 = acc[bj][m][1] * sw;
                u32x4 w; w.x = cvt_pk_bf16(v0[0], v0[1]); w.y = cvt_pk_bf16(v0[2], v0[3]); w.z = cvt_pk_bf16(v1[0], v1[1]); w.w = cvt_pk_bf16(v1[2], v1[3]);
                *(u32x4*)(yb + (size_t)row * D + c0 + bj * 128) = w; } }
    }
};
namespace mg2 {
constexpr int MAXSUB = 5, ASTG = MAXSUB * 8192  , BP = 80, BSTG = 128 * BP  , RSLOT = 16384;
constexpr int OFF_A = 0, OFF_B = 2 * ASTG  , OFF_R = OFF_B + 2 * BSTG  , LDS_END = OFF_R + 3 * RSLOT  ;
__device__ __forceinline__ int swz(int ob) { return ob ^ (((ob >> 9) & 1) << 5); }
__device__ __forceinline__ void dma16_s(const void* sbase, unsigned voff, unsigned lds_dst) {
    unsigned keep;
    asm volatile("s_mov_b32 %0, m0\n\ts_mov_b32 m0, %3\n\ts_nop 0\n\tglobal_load_lds_dwordx4 %1, %2\n\ts_mov_b32 m0, %0" : "=&s"(keep) : "v"(voff), "s"(sbase), "s"(lds_dst) : "memory");
}
struct Unit { int slab, row0, rows_valid; };
template <bool UP, class Epi>
__device__ __forceinline__ void gemm(LAS unsigned char* lds, const bf16_t* Abase, int lda, const int* row_idx, int K, int ldb, const float* W0, const float* W1, size_t wexp,
                                     const LAS int* tstart, const int* cnts, int G, int c, const Epi& E) {
    const int tid = threadIdx.x, wid = __builtin_amdgcn_readfirstlane(tid >> 6), lane = tid & 63, wr = wid >> 1, wc = wid & 1, fr = lane & 15, fq = lane >> 4;
    const int nt = K / 32;
    const bool awave = wid < 4; const int wb = wid & 3;
    const int pA = lane * 16, obA = swz(pA), rrA = obA >> 6, ccA = (obA & 63) >> 1;
    const int aoff = swz(fr * 64 + fq * 16);
    const int boff = OFF_B + (wc * 64 + fr) * BP + fq * 16;
    const int hl = lane >> 5, c4 = lane & 31;
    unsigned wofs_c[2];
#pragma unroll
    for (int j = 0; j < 2; ++j) { const int col = 4 * c4 + 2 * hl + j; int slot;
        if (UP) { const int up = col >> 6, g = col & 63; slot = (g >> 5) * 64 + (up * 2 + ((g >> 4) & 1)) * 16 + (g & 15); } else slot = col;
        wofs_c[j] = (unsigned)(OFF_B + slot * BP + 16 * wb); }
    const int rro_c = OFF_R + (wb * 4) * 1024 + c4 * 16 + hl * 8;
    const unsigned ldsA = (unsigned)(size_t)(lds + OFF_A);
    const int per = G >> 3, xcd = c & 7, rank = c >> 3;
    for (int ui = 0;; ++ui) {
        const int L = (ui * 8 + xcd) * per + rank; if (L >= NE * 16 || rank >= per) break;
        const int e = tstart[80 + (L >> 4)], slab = L & 15, slot0 = tstart[e] * 128, nsub_total = tstart[e + 1] - tstart[e];
        const float* bsrc;
        if (UP) bsrc = (c4 < 16 ? W0 : W1) + (size_t)e * wexp + slab * 64 + 4 * (c4 & 15); else bsrc = W0 + (size_t)e * wexp + slab * 128 + 4 * c4;
        bsrc += (size_t)(8 * wb + hl) * ldb;
        for (int sub0 = 0; sub0 < nsub_total; sub0 += MAXSUB) {
            const int nsub = (nsub_total - sub0) < MAXSUB ? (nsub_total - sub0) : MAXSUB;
            const int rows_valid = (cnts[e] - sub0 * 128) < nsub * 128 ? (cnts[e] - sub0 * 128) : nsub * 128;
            unsigned voff[10];
#pragma unroll
            for (int i = 0; i < 10; ++i) { const int q = i * 4 + wb; int idx = 0;
                if (awave && q * 16 < rows_valid) { const int row = slot0 + sub0 * 128 + 16 * q + rrA; idx = row_idx ? row_idx[row] : row; }
                voff[i] = (unsigned)(idx * lda + ccA) * 2u; }
            if (!awave) { voff[0] = wofs_c[0]; voff[1] = wofs_c[1]; voff[2] = (unsigned)rro_c; voff[3] = (unsigned)(size_t)bsrc; voff[4] = (unsigned)((size_t)bsrc >> 32); }
            f32x4 acc[MAXSUB][2][4];
#pragma unroll
            for (int s = 0; s < MAXSUB; ++s)
#pragma unroll
                for (int m = 0; m < 2; ++m)
#pragma unroll
                    for (int n = 0; n < 4; ++n) acc[s][m][n] = (f32x4){0.f, 0.f, 0.f, 0.f};
#define M2_DMA_A(stage, t) do { const char* _sb = (const char*)Abase + (size_t)(t) * 64; _Pragma("unroll") for (int _i = 0; _i < 10; ++_i) if ((_i * 4 + wb) * 16 < rows_valid) \
        dma16_s(_sb, voff[_i], ldsA + (unsigned)((stage) * ASTG + (_i * 4 + wb) * 1024)); } while (0)
#define M2_DMA_B(rs, t) do { _Pragma("unroll") for (int _i = 0; _i < 4; ++_i) \
        __builtin_amdgcn_global_load_lds((const unsigned*)((const float*)(((size_t)voff[4] << 32) | voff[3]) + (size_t)(32 * (t) + 2 * _i) * ldb), (LAS unsigned*)(lds + OFF_R + (rs) * RSLOT + (wb * 4 + _i) * 1024), 16, 0, 2); } while (0)
#define M2_CVT(rs, stage) do { f32x2 _v[8]; _Pragma("unroll") for (int _i = 0; _i < 4; ++_i) _Pragma("unroll") for (int _h = 0; _h < 2; ++_h) _v[2 * _i + _h] = *(const LAS f32x2*)(lds + voff[2] + (rs) * RSLOT + _i * 1024 + _h * 512); \
        _Pragma("unroll") for (int _j = 0; _j < 2; ++_j) { u32x4 _w; _w.x = cvt_pk_bf16(_v[0][_j], _v[1][_j]); _w.y = cvt_pk_bf16(_v[2][_j], _v[3][_j]); _w.z = cvt_pk_bf16(_v[4][_j], _v[5][_j]); _w.w = cvt_pk_bf16(_v[6][_j], _v[7][_j]); \
            *(LAS u32x4*)(lds + (stage) * BSTG + voff[_j]) = _w; } } while (0)
            if (awave) { M2_DMA_A(0, 0); }
            else { M2_DMA_B(0, 0); M2_DMA_B(1, 1); M2_DMA_B(2, 2); asm volatile("s_waitcnt vmcnt(8)" ::: "memory"); M2_CVT(0, 0); }
            int r1 = 1, r3 = 0;
            for (int t = 0; t < nt; ++t) {
                const int st = t & 1, tn1 = t + 1 < nt ? t + 1 : nt - 1, tn3 = t + 3 < nt ? t + 3 : nt - 1;
                if (awave) asm volatile("s_waitcnt vmcnt(0)" ::: "memory"); else asm volatile("s_waitcnt vmcnt(4)" ::: "memory");
                asm volatile("s_waitcnt lgkmcnt(0)" ::: "memory"); __builtin_amdgcn_s_barrier(); asm volatile("" ::: "memory");
                if (awave) { M2_DMA_A(st ^ 1, tn1); }
                else { M2_CVT(r1, st ^ 1); asm volatile("s_waitcnt lgkmcnt(0)" ::: "memory"); M2_DMA_B(r3, tn3); }
                r1 = r1 == 2 ? 0 : r1 + 1; r3 = r3 == 2 ? 0 : r3 + 1;
                bf16x8 Bf[4];
#pragma unroll
                for (int n = 0; n < 4; ++n) Bf[n] = *(const LAS bf16x8*)(lds + st * BSTG + boff + n * 16 * BP);
#pragma unroll
                for (int s = 0; s < MAXSUB; ++s) if (s * 128 + wr * 32 < rows_valid) {
                    bf16x8 Af[2];
#pragma unroll
                    for (int m = 0; m < 2; ++m) Af[m] = *(const LAS bf16x8*)(lds + OFF_A + st * ASTG + (s * 8 + wr * 2 + m) * 1024 + aoff);
                    __builtin_amdgcn_s_setprio(1);
#pragma unroll
                    for (int m = 0; m < 2; ++m)
#pragma unroll
                        for (int n = 0; n < 4; ++n) acc[s][m][n] = __builtin_amdgcn_mfma_f32_16x16x32_bf16(Bf[n], Af[m], acc[s][m][n], 0, 0, 0);
                    __builtin_amdgcn_s_setprio(0);
                }
            }
            asm volatile("s_waitcnt vmcnt(0)" ::: "memory"); asm volatile("s_waitcnt lgkmcnt(0)" ::: "memory"); __builtin_amdgcn_s_barrier(); asm volatile("" ::: "memory");
            Unit u{slab, slot0 + sub0 * 128, rows_valid};
            E(acc, u, wr, wc, fr, fq);
#undef M2_DMA_A
#undef M2_DMA_B
#undef M2_CVT
        }
    }
}
}

struct EpiSwiglu3 {
    bf16_t* act; const float* slot_rs;
    __device__ __forceinline__ void operator()(const f32x4 (&acc)[mg2::MAXSUB][2][4], const mg2::Unit& u, int wr, int wc, int fr, int fq) const {
#pragma unroll
        for (int s = 0; s < mg2::MAXSUB; ++s)
#pragma unroll
            for (int m = 0; m < 2; ++m) if (s * 128 + wr * 32 + m * 16 < u.rows_valid) { const int row = u.row0 + s * 128 + wr * 32 + m * 16 + fr; const float rs = slot_rs[row];
#pragma unroll
                for (int n = 0; n < 2; ++n) { const f32x4 g = acc[s][m][n] * rs, v = acc[s][m][n + 2] * rs; float o[4];
#pragma unroll
                    for (int j = 0; j < 4; ++j) o[j] = g[j] * fast_sigmoid(g[j]) * v[j];
                    u32x2 w; w.x = cvt_pk_bf16(o[0], o[1]); w.y = cvt_pk_bf16(o[2], o[3]);
                    *(u32x2*)(act + (size_t)row * DE + u.slab * 64 + wc * 32 + n * 16 + 4 * fq) = w; } }
    }
};
struct EpiDown3 {
    bf16_t* yb; const float* slot_w;
    __device__ __forceinline__ void operator()(const f32x4 (&acc)[mg2::MAXSUB][2][4], const mg2::Unit& u, int wr, int wc, int fr, int fq) const {
#pragma unroll
        for (int s = 0; s < mg2::MAXSUB; ++s)
#pragma unroll
            for (int m = 0; m < 2; ++m) if (s * 128 + wr * 32 + m * 16 < u.rows_valid) { const int row = u.row0 + s * 128 + wr * 32 + m * 16 + fr; const float sw = slot_w[row];
#pragma unroll
                for (int n = 0; n < 4; ++n) { const f32x4 v = acc[s][m][n] * sw; u32x2 w; w.x = cvt_pk_bf16(v[0], v[1]); w.y = cvt_pk_bf16(v[2], v[3]);
                    *(u32x2*)(yb + (size_t)row * D + u.slab * 128 + wc * 64 + n * 16 + 4 * fq) = w; } }
    }
};

namespace mg3 {
constexpr int MAXSUB = 5, ASTG = MAXSUB * 128 * 32  , BP = 40, BSTG = 128 * BP  , RSLOT = 16384;
constexpr int OFF_A = 0, OFF_B = 3 * ASTG  , OFF_R = OFF_B + 2 * BSTG  , LDS_END = OFF_R + 4 * RSLOT  ;
constexpr float WSCALE = 64.f, WINV = 1.f / 64.f;
struct Unit { int slab, row0, rows_valid, lbase; };
#define M3_WAITV(np) do { if ((np) >= 5) asm volatile("s_waitcnt vmcnt(5)" ::: "memory"); else if ((np) == 4) asm volatile("s_waitcnt vmcnt(4)" ::: "memory"); else if ((np) == 3) asm volatile("s_waitcnt vmcnt(3)" ::: "memory"); \
        else if ((np) == 2) asm volatile("s_waitcnt vmcnt(2)" ::: "memory"); else if ((np) == 1) asm volatile("s_waitcnt vmcnt(1)" ::: "memory"); else asm volatile("s_waitcnt vmcnt(0)" ::: "memory"); } while (0)
__device__ __forceinline__ void dma16_v_nt(const void* vaddr, unsigned lds_dst) {
    unsigned keep;
    asm volatile("s_mov_b32 %0, m0\n\ts_mov_b32 m0, %2\n\ts_nop 0\n\tglobal_load_lds_dwordx4 %1, off nt\n\ts_mov_b32 m0, %0" : "=&s"(keep) : "v"(vaddr), "s"(lds_dst) : "memory");
}
template <bool UP, class Epi>
__device__ __forceinline__ void gemm(LAS unsigned char* lds, const unsigned char* Abase, int lda, const int* ltok, int K, int ldb, const float* W0, const float* W1, size_t wexp,
                                     const LAS int* tstart, const int* cnts, int G, int c, const Epi& E) {
    const int tid = threadIdx.x, wid = __builtin_amdgcn_readfirstlane(tid >> 6), lane = tid & 63, wr = wid >> 1, wc = wid & 1, fr = lane & 15, fq = lane >> 4;
    const int nt = K / 32;
    const bool awave = wid < 4; const int wb = wid & 3;
    const int aoff = OFF_A + (wr * 32 + fr) * 32 + fq * 8;
    const int boff = OFF_B + (wc * 64 + fr) * BP + fq * 8;
    const int hl = lane >> 5, c4 = lane & 31;
    unsigned wofs_c[2];
#pragma unroll
    for (int j = 0; j < 2; ++j) { const int col = 4 * c4 + 2 * hl + j; int slot;
        if (UP) { const int up = col >> 6, g = col & 63; slot = (g >> 5) * 64 + (up * 2 + ((g >> 4) & 1)) * 16 + (g & 15); } else slot = col;
        wofs_c[j] = (unsigned)(OFF_B + slot * BP + 8 * wb); }
    const int rro_c = OFF_R + (wb * 4) * 1024 + c4 * 16 + hl * 8;
    const unsigned ldsA = (unsigned)(size_t)(lds + OFF_A), ldsR = (unsigned)(size_t)(lds + OFF_R);
    const int per = G >> 3, xcd = c & 7, rank = c >> 3;
    for (int ui = 0;; ++ui) {
        const int L = (ui * 8 + xcd) * per + rank; if (L >= NE * 16 || rank >= per) break;
        const int e = tstart[80 + (L >> 4)], slab = L & 15, slot0 = tstart[e] * 128, nsub_total = tstart[e + 1] - tstart[e];
        const float* bsrc;
        if (UP) bsrc = (c4 < 16 ? W0 : W1) + (size_t)e * wexp + slab * 64 + 4 * (c4 & 15); else bsrc = W0 + (size_t)e * wexp + slab * 128 + 4 * c4;
        bsrc += (size_t)(8 * wb + hl) * ldb;
        for (int sub0 = 0; sub0 < nsub_total; sub0 += MAXSUB) {
            const int nsub = (nsub_total - sub0) < MAXSUB ? (nsub_total - sub0) : MAXSUB;
            const int rows_valid = (cnts[e] - sub0 * 128) < nsub * 128 ? (cnts[e] - sub0 * 128) : nsub * 128;
            unsigned voff[5]; int np = 0;
#pragma unroll
            for (int i = 0; i < 5; ++i) { const int q = i * 4 + wb; int idx = 0;
                if (awave && q * 32 < rows_valid) { const int lrow = sub0 * 128 + 32 * q + (lane >> 1); idx = ltok ? (lrow < cnts[e] ? ltok[e * T + lrow] : 0) : slot0 + lrow; ++np; }
                voff[i] = (unsigned)(idx * lda + (lane & 1) * 16); }
            if (!awave) { voff[0] = wofs_c[0]; voff[1] = wofs_c[1]; voff[2] = (unsigned)rro_c; voff[3] = (unsigned)(size_t)bsrc; voff[4] = (unsigned)((size_t)bsrc >> 32); }
            f32x4 acc[MAXSUB][2][4];
#pragma unroll
            for (int s = 0; s < MAXSUB; ++s)
#pragma unroll
                for (int m = 0; m < 2; ++m)
#pragma unroll
                    for (int n = 0; n < 4; ++n) acc[s][m][n] = (f32x4){0.f, 0.f, 0.f, 0.f};
#define M3_DMA_A(stage, t) do { const char* _sb = (const char*)Abase + (size_t)(t) * 32; _Pragma("unroll") for (int _i = 0; _i < 5; ++_i) if ((_i * 4 + wb) * 32 < rows_valid) \
        mg2::dma16_s(_sb, voff[_i], ldsA + (unsigned)((stage) * ASTG + (_i * 4 + wb) * 1024)); } while (0)
#define M3_DMA_B(rs, t) do { _Pragma("unroll") for (int _i = 0; _i < 4; ++_i) \
        dma16_v_nt((const float*)(((size_t)voff[4] << 32) | voff[3]) + (size_t)(32 * (t) + 2 * _i) * ldb, ldsR + (unsigned)((rs) * RSLOT + (wb * 4 + _i) * 1024)); } while (0)
#define M3_CVT_LOAD(rs) do { _Pragma("unroll") for (int _i = 0; _i < 4; ++_i) _Pragma("unroll") for (int _h = 0; _h < 2; ++_h) rv[2 * _i + _h] = *(const LAS f32x2*)(lds + voff[2] + (rs) * RSLOT + _i * 1024 + _h * 512); } while (0)
#define M3_CVT_STORE(stage) do { _Pragma("unroll") for (int _j = 0; _j < 2; ++_j) { u32x2 _w; _w.x = pk4_fp8(rv[0][_j] * WSCALE, rv[1][_j] * WSCALE, rv[2][_j] * WSCALE, rv[3][_j] * WSCALE); \
            _w.y = pk4_fp8(rv[4][_j] * WSCALE, rv[5][_j] * WSCALE, rv[6][_j] * WSCALE, rv[7][_j] * WSCALE); *(LAS u32x2*)(lds + (stage) * BSTG + voff[_j]) = _w; } } while (0)
            f32x2 rv[8];
#pragma unroll
            for (int i = 0; i < 8; ++i) rv[i] = (f32x2){0.f, 0.f};
            if (awave) { M3_DMA_A(0, 0); M3_DMA_A(1, 1); }
            else { M3_DMA_B(0, 0); M3_DMA_B(1, 1); M3_DMA_B(2, 2); M3_DMA_B(3, 3); asm volatile("s_waitcnt vmcnt(12)" ::: "memory"); M3_CVT_LOAD(0); M3_CVT_STORE(0);
                   asm volatile("s_waitcnt vmcnt(8)" ::: "memory"); M3_CVT_LOAD(1); }
            int sA = 0, sA2 = 2;
            for (int t = 0; t < nt; ++t) {
                const int st = t & 1, tn2 = t + 2 < nt ? t + 2 : nt - 1, tn4 = t + 4 < nt ? t + 4 : nt - 1;
                if (awave) { M3_WAITV(np); }
                asm volatile("s_waitcnt lgkmcnt(0)" ::: "memory"); __builtin_amdgcn_s_barrier(); asm volatile("" ::: "memory");
                if (awave) { M3_DMA_A(sA2, tn2); }
                else { M3_CVT_STORE(st ^ 1); M3_DMA_B(t & 3, tn4); }
                long Bf[4];
#pragma unroll
                for (int n = 0; n < 4; ++n) Bf[n] = *(const LAS long*)(lds + st * BSTG + boff + n * 16 * BP);
#pragma unroll
                for (int s = 0; s < MAXSUB; ++s) if (s * 128 + wr * 32 < rows_valid) {
                    long Af[2];
#pragma unroll
                    for (int m = 0; m < 2; ++m) Af[m] = *(const LAS long*)(lds + sA * ASTG + aoff + (s * 128 + m * 16) * 32);
                    __builtin_amdgcn_s_setprio(1);
#pragma unroll
                    for (int m = 0; m < 2; ++m)
#pragma unroll
                        for (int n = 0; n < 4; ++n) acc[s][m][n] = __builtin_amdgcn_mfma_f32_16x16x32_fp8_fp8(Bf[n], Af[m], acc[s][m][n], 0, 0, 0);
                    __builtin_amdgcn_s_setprio(0);
                }
                sA = sA == 2 ? 0 : sA + 1; sA2 = sA2 == 2 ? 0 : sA2 + 1;
                if (!awave) { asm volatile("s_waitcnt vmcnt(8)" ::: "memory"); M3_CVT_LOAD((t + 2) & 3); }
            }
            asm volatile("s_waitcnt vmcnt(0)" ::: "memory"); asm volatile("s_waitcnt lgkmcnt(0)" ::: "memory"); __builtin_amdgcn_s_barrier(); asm volatile("" ::: "memory");
            Unit u{slab, slot0 + sub0 * 128, rows_valid, e * T + sub0 * 128};
            E(acc, u, wr, wc, fr, fq);
#undef M3_DMA_A
#undef M3_DMA_B
#undef M3_CVT_LOAD
#undef M3_CVT_STORE
        }
    }
}
}
struct EpiSwiglu8 {
    unsigned char* actq; const float* slot_rs;
    __device__ __forceinline__ void operator()(const f32x4 (&acc)[mg3::MAXSUB][2][4], const mg3::Unit& u, int wr, int wc, int fr, int fq) const {
        float rsv[mg3::MAXSUB][2];
#pragma unroll
        for (int s = 0; s < mg3::MAXSUB; ++s)
#pragma unroll
            for (int m = 0; m < 2; ++m) rsv[s][m] = (s * 128 + wr * 32 + m * 16 < u.rows_valid) ? slot_rs[u.lbase + s * 128 + wr * 32 + m * 16 + fr] : 0.f;
#pragma unroll
        for (int s = 0; s < mg3::MAXSUB; ++s)
#pragma unroll
            for (int m = 0; m < 2; ++m) if (s * 128 + wr * 32 + m * 16 < u.rows_valid) { const int lr = s * 128 + wr * 32 + m * 16 + fr, row = u.row0 + lr; const float rs = rsv[s][m] * mg3::WINV;
                unsigned pq[2];
#pragma unroll
                for (int n = 0; n < 2; ++n) { const f32x4 g = acc[s][m][n] * rs, v = acc[s][m][n + 2] * rs; float o[4];
#pragma unroll
                    for (int j = 0; j < 4; ++j) o[j] = clamp448(g[j] * fast_sigmoid(g[j]) * v[j]);
                    pq[n] = pk4_fp8(o[0], o[1], o[2], o[3]); }
                const u32x2 sw = __builtin_amdgcn_permlane16_swap(pq[0], pq[1], false, false);
                *(u32x2*)(actq + (size_t)row * DE + u.slab * 64 + wc * 32 + (fq & 1) * 16 + (fq >> 1) * 8) = sw; }
    }
};
struct EpiDown8 {
    unsigned char* yq; const float* slot_w;
    __device__ __forceinline__ void operator()(const f32x4 (&acc)[mg3::MAXSUB][2][4], const mg3::Unit& u, int wr, int wc, int fr, int fq) const {
        float swv[mg3::MAXSUB][2];
#pragma unroll
        for (int s = 0; s < mg3::MAXSUB; ++s)
#pragma unroll
            for (int m = 0; m < 2; ++m) swv[s][m] = (s * 128 + wr * 32 + m * 16 < u.rows_valid) ? slot_w[u.lbase + s * 128 + wr * 32 + m * 16 + fr] : 0.f;
#pragma unroll
        for (int s = 0; s < mg3::MAXSUB; ++s)
#pragma unroll
            for (int m = 0; m < 2; ++m) if (s * 128 + wr * 32 + m * 16 < u.rows_valid) { const int lr = s * 128 + wr * 32 + m * 16 + fr, row = u.row0 + lr; const float sw = swv[s][m] * (mg3::WINV * 16.f);
                unsigned r[4];
#pragma unroll
                for (int n = 0; n < 4; ++n) { const f32x4 v = acc[s][m][n] * sw; r[n] = pk4_fp8(clamp448(v[0]), clamp448(v[1]), clamp448(v[2]), clamp448(v[3])); }
                const u32x2 a02 = __builtin_amdgcn_permlane32_swap(r[0], r[2], false, false), a13 = __builtin_amdgcn_permlane32_swap(r[1], r[3], false, false);
                const u32x2 b01 = __builtin_amdgcn_permlane16_swap(a02.x, a13.x, false, false), b23 = __builtin_amdgcn_permlane16_swap(a02.y, a13.y, false, false);
                u32x4 o; o.x = b01.x; o.y = b01.y; o.z = b23.x; o.w = b23.y;
                *(u32x4*)(yq + (size_t)row * D + u.slab * 128 + wc * 64 + 16 * fq) = o; }
    }
};
constexpr int PH_PROLOGUE = 0, PH_GEMM1 = 1, PH_GMLP = 2, PH_H1 = 3, PH_H2 = 4, PH_H3 = 5, PH_PAB = 6, PH_OUT = 7, PH_ROUTE = 8, PH_ASSIGN = 9, PH_MOEUP = 10, PH_MOEDN = 11, PH_FINAL = 12, PH_END = 13;
__global__ void __launch_bounds__(NTHR, 2) mega(Args args) {
    extern __shared__ __attribute__((aligned(16))) unsigned char lds_raw[];
    Frame F;
    F.lds = (LAS unsigned char*)lds_raw; F.MISC = (volatile LAS unsigned*)(F.lds + MISC_OFF);
    F.tid = threadIdx.x; F.lane = F.tid & 63; F.wave = __builtin_amdgcn_readfirstlane(F.tid >> 6);
    F.G = gridDim.x; F.bid = blockIdx.x; F.a = &args; F.ws = args.ws;
    unsigned char* ws = args.ws;
    for (int u = F.tid; u < (LDS_BYTES - RING_BYTES) / 4; u += NTHR) ((LAS unsigned*)(F.lds + RING_BYTES))[u] = 0u;
    __syncthreads();
    XcdBarrier bar = xcd_barrier_post((unsigned*)(ws + WS_CTL) + CW_BAR, F.MISC + 8);
    const int lo = args.ph_lo, hi = args.ph_hi;
#define IN(k) (lo <= (k) && (k) < hi)
#define SEAM(k) do { if (IN(k) && IN((k) + 1)) xcd_barrier(bar); } while (0)

    if (IN(PH_PROLOGUE)) { build_router_weights(F); p0_prologue(F, TR_ITEMS_SMALL); }
    SEAM(PH_PROLOGUE);
    if (IN(PH_GEMM1)) {
        pg8::Shape g{D, D, D}; pg8::StaticOrder S; S.init(ws + WS_H, ws + WS_WTIN, T, NZ, D, D, F.G, F.bid);
        EpiZ E{ws, args.in[7]};
        pg8::gemm_phase<EpiZ, pg8::StaticOrder>(F.lds, g, S, E);
    }
    SEAM(PH_GEMM1);
    if (IN(PH_GMLP)) { gmlp_phase(F); }
    if (IN(PH_H1)) { hgrn_h1_phase(F); }
    SEAM(PH_H1);
    if (IN(PH_H2)) { hgrn_h2_phase(F); }
    SEAM(PH_H2);
    if (IN(PH_H3)) { hgrn_h3_phase(F); }
    SEAM(PH_H3);
    if (IN(PH_PAB)) {
        pg8::Shape g{2048, 2048, 2048}; pg8::StaticOrder S; S.init(ws + WS_YAB, ws + WS_WTPAB, T, D, 2048, 2048, F.G, F.bid);
        EpiMerge E{(const bf16_t*)(ws + WS_SGA), (const bf16_t*)(ws + WS_SGB), (bf16_t*)(ws + WS_MERGED)};
        pg8::gemm_phase<EpiMerge, pg8::StaticOrder>(F.lds, g, S, E);
    }
    SEAM(PH_PAB);
    if (IN(PH_OUT)) {
        pg8::Shape g{D, D, D}; pg8::StaticOrder S; S.init(ws + WS_MERGED, ws + WS_WTOUT, T, D, D, D, F.G, F.bid);
        EpiRes E{args.in[0], (bf16_t*)(ws + WS_YAB)};
        pg8::gemm_phase<EpiRes, pg8::StaticOrder>(F.lds, g, S, E);
    }
    SEAM(PH_OUT);
    if (IN(PH_ROUTE)) { route_phase(F); }
    SEAM(PH_ROUTE);
    if (IN(PH_MOEUP)) {
        LAS int* tstart = (LAS int*)(F.lds + RING_BYTES - 1024); moe_tile_table128(F, tstart);
        EpiSwiglu8 E{ws + WS_ACT, (const float*)(ws + WS_LRS)};
        mg3::gemm<true, EpiSwiglu8>(F.lds, ws + WS_H, D, (const int*)(ws + WS_LTOK), D, DE, args.in[17], args.in[18], (size_t)D * DE, tstart, (const int*)(ws + WS_CTL) + CW_COUNTS, F.G, F.bid, E);
    }
    SEAM(PH_MOEUP);
    if (IN(PH_MOEDN)) {
        LAS int* tstart = (LAS int*)(F.lds + RING_BYTES - 1024); moe_tile_table128(F, tstart);
        EpiDown8 E{ws + WS_YB, (const float*)(ws + WS_LW)};
        mg3::gemm<false, EpiDown8>(F.lds, ws + WS_ACT, DE, nullptr, DE, D, args.in[19], args.in[19], (size_t)DE * D, tstart, (const int*)(ws + WS_CTL) + CW_COUNTS, F.G, F.bid, E);
    }
    SEAM(PH_MOEDN);
    if (IN(PH_FINAL)) { final_phase(F); }
#undef IN
#undef SEAM
}
}

extern "C" void kernel_launch(void* const* d_in, const int* in_sizes, int n_in, void* d_out, int out_size, void* d_ws, size_t ws_size, hipStream_t stream) {
    static int grid = 0;
    if (grid == 0) {
        int dev = 0, cus = 0, per_cu = 0;
        if (hipGetDevice(&dev) != hipSuccess || hipDeviceGetAttribute(&cus, hipDeviceAttributeMultiprocessorCount, dev) != hipSuccess) { fprintf(stderr, "kernel_launch: device query failed\n"); grid = -1; return; }
        if (hipFuncSetAttribute((const void*)mega, hipFuncAttributeMaxDynamicSharedMemorySize, LDS_BYTES) != hipSuccess) { fprintf(stderr, "kernel_launch: hipFuncSetAttribute failed\n"); grid = -1; return; }
        if (hipOccupancyMaxActiveBlocksPerMultiprocessor(&per_cu, (const void*)mega, NTHR, LDS_BYTES) != hipSuccess || per_cu < 1) fprintf(stderr, "kernel_launch: occupancy query reports %d\n", per_cu);
        (void)hipGetLastError();
        grid = cus;
    }
    if (grid < 0) return;
    const float* x = (const float*)d_in[0];
    float* out = (float*)d_out;
    unsigned char* ws = (unsigned char*)d_ws;
    if (ws_size < WS_END) { fprintf(stderr, "kernel_launch: workspace too small (%zu)\n", ws_size); return; }
    (void)hipMemsetAsync(ws + WS_CTL, 0, CTL_ZERO_BYTES, stream);
    Args a{};
    for (int i = 0; i < 21; ++i) a.in[i] = (const float*)d_in[i];
    a.out = out; a.ws = ws;
    auto launch = [&](int lo, int hi) { a.ph_lo = lo; a.ph_hi = hi; hipLaunchKernelGGL(mega, dim3(grid), dim3(NTHR), LDS_BYTES, stream, a); };
    launch(0, PH_END);
}
```

```cpp
#include <hip/hip_runtime.h>
#include <stdint.h>
#include <stdio.h>

namespace {
constexpr int T = 16384, D = 2048, NZ = 10240, GW = 1024, NE = 64, DE = 1024;
constexpr float EPS = 1e-6f;
constexpr int NWAVES = 8, NTHR = 512;
constexpr int PMAX = 32768 + 64 * 256;
constexpr int MT_MAX = PMAX / 256;

#define LAS __attribute__((address_space(3)))
#define GAS __attribute__((address_space(1)))
typedef unsigned short bf16_t;
typedef short bf16x8 __attribute__((ext_vector_type(8)));
typedef short bf16x4 __attribute__((ext_vector_type(4)));
typedef float f32x4 __attribute__((ext_vector_type(4)));
typedef float f32x2 __attribute__((ext_vector_type(2)));
typedef unsigned u32x4 __attribute__((ext_vector_type(4)));
typedef unsigned u32x2 __attribute__((ext_vector_type(2)));

constexpr size_t MiB = 1u << 20;
constexpr size_t WS_CTL = 0, CTL_ZERO_BYTES = 32 * 1024;
constexpr size_t WS_ROWIDX = 2 * MiB;
constexpr size_t WS_SLOTOF = WS_ROWIDX + 256 * 1024;
constexpr size_t WS_TOKE = WS_SLOTOF + 128 * 1024;
constexpr size_t WS_TOKW = WS_TOKE + 128 * 1024;
constexpr size_t WS_SLOTW = WS_TOKW + 128 * 1024;
constexpr size_t WS_RSTD2 = WS_SLOTW + 256 * 1024;
constexpr size_t WS_SLOTRS = WS_RSTD2 + 64 * 1024;
constexpr size_t WS_WRT = 7 * MiB;
constexpr size_t WS_ROWSTAT = 4 * MiB;
constexpr size_t WS_DC = 6 * MiB;
constexpr size_t WS_WTIN = 8 * MiB;
constexpr size_t WS_WTPAB = 48 * MiB;
constexpr size_t WS_WTOUT = 56 * MiB;
constexpr size_t WS_H = 64 * MiB;
constexpr size_t WS_GU = 128 * MiB, WS_GV = 160 * MiB, WS_QB = 192 * MiB, WS_IB = 256 * MiB, WS_SG = 288 * MiB;
constexpr size_t WS_LF = 320 * MiB;
constexpr size_t WS_SGA = 384 * MiB, WS_SGB = 448 * MiB;
constexpr size_t WS_YAB = 512 * MiB;
constexpr size_t WS_HBUF = 576 * MiB;
constexpr size_t WS_SBUF = 640 * MiB;
constexpr size_t WS_LTOK = 640 * MiB, WS_LW = 644 * MiB, WS_LRS = 648 * MiB;
constexpr size_t WS_MERGED = 672 * MiB;
constexpr size_t WS_WGU = 736 * MiB;
constexpr size_t WS_WD = 1248 * MiB;
constexpr size_t WS_END = 1504 * MiB;
constexpr size_t WS_XG = 128 * MiB;
constexpr size_t WS_ACT = 320 * MiB;
constexpr size_t WS_YB = 416 * MiB;
constexpr int CW_COUNTS = 16, CW_CURSOR = 96;
constexpr int CW_BAR = 4096;

constexpr int RING_BYTES = 155648;
constexpr int MISC_OFF = RING_BYTES + 64;
constexpr int LDS_BYTES = RING_BYTES + 1024;

__device__ __forceinline__ float wave_sum(float v) {
#pragma unroll
    for (int o = 32; o >= 1; o >>= 1) v += __shfl_xor(v, o);
    return v;
}
__device__ __forceinline__ unsigned cvt_pk_bf16(float lo, float hi) { unsigned r; asm volatile("v_cvt_pk_bf16_f32 %0, %1, %2" : "=v"(r) : "v"(lo), "v"(hi)); return r; }
__device__ __forceinline__ unsigned cvt_pk_bf16_m(float lo, float hi) { unsigned r; asm volatile("v_cvt_pk_bf16_f32 %0, %1, %2\n\ts_nop 1" : "=v"(r) : "v"(lo), "v"(hi)); return r; }
__device__ __forceinline__ unsigned cvt_pk_bf16_d(float lo, float hi) { unsigned r; asm volatile("s_nop 7\n\ts_nop 3\n\tv_cvt_pk_bf16_f32 %0, %1, %2\n\ts_nop 1" : "=v"(r) : "v"(lo), "v"(hi)); return r; }
__device__ __forceinline__ float bf_lo(unsigned w) { return __uint_as_float(w << 16); }
__device__ __forceinline__ float bf_hi(unsigned w) { return __uint_as_float(w & 0xffff0000u); }
__device__ __forceinline__ float bf2f(bf16_t b) { return __uint_as_float(((unsigned)b) << 16); }
__device__ __forceinline__ float fast_sigmoid(float x) { return __builtin_amdgcn_rcpf(1.f + __builtin_amdgcn_exp2f(-1.4426950408889634f * x)); }
__device__ __forceinline__ float fast_gelu(float x) { const float u = x * (0.7978845608028654f + 0.035677408136300125f * x * x); return x * __builtin_amdgcn_rcpf(1.f + __builtin_amdgcn_exp2f(-2.8853900817779268f * u)); }
__device__ __forceinline__ float fast_exp(float x) { return __builtin_amdgcn_exp2f(1.4426950408889634f * x); }
__device__ __forceinline__ float fast_log(float x) { return 0.6931471805599453f * __builtin_amdgcn_logf(x); }
__device__ __forceinline__ float clamp448(float v) { return __builtin_fminf(__builtin_fmaxf(v, -448.f), 448.f); }
__device__ __forceinline__ unsigned pk4_fp8(float a, float b, float c, float d) { int r = __builtin_amdgcn_cvt_pk_fp8_f32(a, b, 0, false); r = __builtin_amdgcn_cvt_pk_fp8_f32(c, d, r, true); return (unsigned)r; }
namespace pg8 {
constexpr int BM = 256, BK = 64, HALF = 128, HTB = HALF * BK * 2, STAGE_BYTES = 8 * HTB, NXCD = 8, WGM = 4;
__host__ __device__ __forceinline__ int lds_byte(int r, int c) { const int st = (r >> 4) * 2 + (c >> 5), rr = r & 15, cc = c & 31, ob = rr * 64 + cc * 2; return st * 1024 + (ob ^ (((ob >> 9) & 1) << 5)); }
__host__ __device__ __forceinline__ void stage_rc(int b, int& R, int& C) { const int st = b / 1024, sb = b % 1024, swz = sb ^ (((sb >> 9) & 1) << 5); R = (st >> 1) * 16 + swz / 64; C = (st & 1) * 32 + (swz % 64) / 2; }
__host__ __device__ __forceinline__ int perm32(int rho) { const int n = rho >> 4, i = rho & 15; return 8 * (i >> 2) + 4 * n + (i & 3); }

struct Unit { const char* A; const char* B; int pm, pn, aux; };
struct Shape { int K, lda, ldb; };

struct StaticOrder {
    const char* A; const char* Bt; size_t a_tile, b_tile; int nM, nN, nwg, G, c;
    __device__ void init(const void* A_, const void* Bt_, int M, int N, int lda, int ldb, int G_, int c_) { A = (const char*)A_; Bt = (const char*)Bt_; a_tile = (size_t)BM * lda * 2; b_tile = (size_t)BM * ldb * 2; nM = M / BM; nN = N / BM; nwg = nM * nN; G = G_; c = c_; }
    __device__ bool next(int i, Unit& u) const {
        const long L = (long)i * G + c; if (L >= nwg) return false;
        int wgid = (int)L; { const int q = nwg / NXCD, r = nwg % NXCD, xcd = wgid % NXCD, off = wgid / NXCD; wgid = (xcd < r ? xcd * (q + 1) : r * (q + 1) + (xcd - r) * q) + off; }
        const int nig = WGM * nN, gid = wgid / nig, fm = gid * WGM, gsz = (nM - fm) < WGM ? (nM - fm) : WGM;
        u.pm = fm + ((wgid % nig) % gsz); u.pn = (wgid % nig) / gsz; u.aux = 0;
        u.A = A + (size_t)u.pm * a_tile; u.B = Bt + (size_t)u.pn * b_tile; return true;
    }
};

template <class Epi, class Sched>
__device__ __forceinline__ void gemm_phase(LAS unsigned char* lds, const Shape g, const Sched& S, const Epi& E) {
    const int tid = threadIdx.x, wid = __builtin_amdgcn_readfirstlane(tid >> 6), lane = tid & 63, wr = wid >> 2, wc = wid & 3, fr = lane & 15, fq = lane >> 4;
    const int K = g.K, nt = K / BK;
    unsigned voffA[2], voffB[2];
#pragma unroll
    for (int i = 0; i < 2; ++i) { int R, C; stage_rc(tid * 16 + i * 8192, R, C); const int Rb = Epi::PERM ? ((R & ~31) + perm32(R & 31)) : R;
        voffA[i] = (unsigned)(R * g.lda + C) * 2u; voffB[i] = (unsigned)(Rb * g.ldb + C) * 2u; }
    const size_t kstep = (size_t)(BK * 2);
    const size_t hstepA = (size_t)HALF * g.lda * 2, hstepB = (size_t)HALF * g.ldb * 2;
    const unsigned ldsw = (unsigned)wid * 1024u;
    const int aoff = lds_byte(wr * 64 + fr, fq * 8), boff = lds_byte(wc * 32 + fr, fq * 8);
#define PG8_SA(b, h) (((b) * 2 + (h)) * HTB)
#define PG8_SB(b, h) ((4 + (b) * 2 + (h)) * HTB)
#define PG8_STAGE(bufoff, gbase, voff) do { _Pragma("unroll") for (int _i = 0; _i < 2; ++_i) \
        __builtin_amdgcn_global_load_lds((const unsigned*)((const char*)(gbase) + (voff)[_i]), (LAS unsigned*)(lds + (bufoff) + ldsw + _i * 8192), 16, 0, 0); } while (0)
#define PG8_LDA(dst, b, h) do { _Pragma("unroll") for (int m = 0; m < 4; ++m) _Pragma("unroll") for (int k = 0; k < 2; ++k) dst[m][k] = *(const LAS bf16x8*)(lds + PG8_SA(b, h) + aoff + m * 2048 + k * 1024); } while (0)
#define PG8_LDB(dst, b, h) do { _Pragma("unroll") for (int n = 0; n < 2; ++n) _Pragma("unroll") for (int k = 0; k < 2; ++k) dst[n][k] = *(const LAS bf16x8*)(lds + PG8_SB(b, h) + boff + n * 2048 + k * 1024); } while (0)
#define PG8_MMA(ai, bj, At, Bt) do { __builtin_amdgcn_s_setprio(1); _Pragma("unroll") for (int m = 0; m < 4; ++m) _Pragma("unroll") for (int n = 0; n < 2; ++n) _Pragma("unroll") for (int k = 0; k < 2; ++k) \
        acc[ai][bj][m][n] = __builtin_amdgcn_mfma_f32_16x16x32_bf16(Bt[n][k], At[m][k], acc[ai][bj][m][n], 0, 0, 0); __builtin_amdgcn_s_setprio(0); } while (0)
#define PG8_WAIT_V(n) asm volatile("s_waitcnt vmcnt(" #n ")" ::: "memory")
#define PG8_WAIT_L(n) asm volatile("s_waitcnt lgkmcnt(" #n ")" ::: "memory")
#define PG8_BAR __builtin_amdgcn_s_barrier()
#define PG8_SCHED __builtin_amdgcn_sched_barrier(0)
    Unit cur, nxt; int ui = 0;
    if (!S.next(0, cur)) return;
    f32x4 acc[2][2][4][2];
#pragma unroll
    for (int a = 0; a < 2; ++a)
#pragma unroll
        for (int b = 0; b < 2; ++b)
#pragma unroll
            for (int m = 0; m < 4; ++m)
#pragma unroll
                for (int n = 0; n < 2; ++n) acc[a][b][m][n] = (f32x4){0.f, 0.f, 0.f, 0.f};
    bf16x8 At[4][2], B0[2][2], B1[2][2];
    const char* cA = cur.A; const char* cB = cur.B;
    PG8_STAGE(PG8_SB(0, 0), cB, voffB); PG8_STAGE(PG8_SB(0, 1), cB + hstepB, voffB); PG8_STAGE(PG8_SA(0, 0), cA, voffA); PG8_STAGE(PG8_SA(0, 1), cA + hstepA, voffA);
    if (wr == 1) PG8_BAR;
    PG8_WAIT_V(2); PG8_BAR;
    PG8_STAGE(PG8_SB(1, 0), cB + kstep, voffB); PG8_STAGE(PG8_SA(1, 0), cA + kstep, voffA); PG8_STAGE(PG8_SB(1, 1), cB + hstepB + kstep, voffB);
    PG8_WAIT_V(6); PG8_BAR;
    for (;;) {
        const bool has_next = S.next(ui + 1, nxt);
        const char* nA = has_next ? nxt.A : cA; const char* nB = has_next ? nxt.B : cB;
        for (int t = 0; t < nt; t += 2) {
            const bool last = (t == nt - 2);
            const char* a1 = cA + (size_t)(t + 1) * kstep;
            const char* a2 = last ? nA : cA + (size_t)(t + 2) * kstep; const char* b2 = last ? nB : cB + (size_t)(t + 2) * kstep;
            const char* a3 = a2 + kstep; const char* b3 = b2 + kstep;
            if constexpr (Epi::HAS_MID) { if (t == nt / 2) E.mid(acc, cur, wr, wc, fr, fq); }
            PG8_LDB(B0, 0, 0); PG8_LDB(B1, 0, 1); PG8_SCHED; PG8_LDA(At, 0, 0); PG8_STAGE(PG8_SA(1, 1), a1 + hstepA, voffA);
            PG8_WAIT_V(8); PG8_WAIT_L(0); PG8_BAR; PG8_MMA(0, 0, At, B0); PG8_MMA(0, 1, At, B1); PG8_BAR; PG8_SCHED;
            PG8_LDA(At, 0, 1); PG8_STAGE(PG8_SB(0, 0), b2, voffB); PG8_STAGE(PG8_SB(0, 1), b2 + hstepB, voffB); PG8_STAGE(PG8_SA(0, 0), a2, voffA);
            PG8_WAIT_V(8); PG8_WAIT_L(0); PG8_BAR; PG8_MMA(1, 0, At, B0); PG8_MMA(1, 1, At, B1); PG8_BAR; PG8_SCHED;
            PG8_LDB(B0, 1, 0); PG8_LDB(B1, 1, 1); PG8_SCHED; PG8_LDA(At, 1, 0); PG8_STAGE(PG8_SA(0, 1), a2 + hstepA, voffA);
            PG8_WAIT_V(8); PG8_WAIT_L(0); PG8_BAR; PG8_MMA(0, 0, At, B0); PG8_MMA(0, 1, At, B1); PG8_BAR; PG8_SCHED;
            PG8_LDA(At, 1, 1); PG8_STAGE(PG8_SB(1, 0), b3, voffB); PG8_STAGE(PG8_SB(1, 1), b3 + hstepB, voffB); PG8_STAGE(PG8_SA(1, 0), a3, voffA);
            PG8_WAIT_V(8); PG8_WAIT_L(0); PG8_BAR; PG8_MMA(1, 0, At, B0); PG8_MMA(1, 1, At, B1); PG8_BAR; PG8_SCHED;
        }
        if (wr == 0) PG8_BAR;
        E(acc, cur, wr, wc, fr, fq);
        if (!has_next) break;
#pragma unroll
        for (int a = 0; a < 2; ++a)
#pragma unroll
            for (int b = 0; b < 2; ++b)
#pragma unroll
                for (int m = 0; m < 4; ++m)
#pragma unroll
                    for (int n = 0; n < 2; ++n) acc[a][b][m][n] = (f32x4){0.f, 0.f, 0.f, 0.f};
        cur = nxt; cA = nA; cB = nB; ++ui;
        if (wr == 1) PG8_BAR;
    }
    PG8_WAIT_V(0);
    PG8_BAR;
#undef PG8_SA
#undef PG8_SB
#undef PG8_STAGE
#undef PG8_LDA
#undef PG8_LDB
#undef PG8_MMA
#undef PG8_WAIT_V
#undef PG8_WAIT_L
#undef PG8_BAR
#undef PG8_SCHED
}
}
struct EpiZ {
    static constexpr bool PERM = true, HAS_MID = false;
    unsigned char* ws; const float* lbl;
    __device__ __forceinline__ void mid(f32x4 (&)[2][2][4][2], const pg8::Unit&, int, int, int, int) const {}
    __device__ __forceinline__ void operator()(const f32x4 (&acc)[2][2][4][2], const pg8::Unit& u, int wr, int wc, int fr, int fq) const {
        const int pn = u.pn, row0 = u.pm * 256 + wr * 64 + fr;
        int kind, ldc, c0; bf16_t* base = nullptr;
        if (pn < 24) { const int seg = pn >> 2; c0 = (pn & 3) * 256 + wc * 32 + 8 * fq; ldc = 1024; kind = seg;
            base = (bf16_t*)(ws + WS_GU + (size_t)seg * (32 * MiB)); }
        else { kind = 6; ldc = 2048; c0 = ((pn - 24) & 7) * 256 + wc * 32 + 8 * fq; base = (bf16_t*)(ws + WS_SGA + (size_t)((pn - 24) >> 3) * (64 * MiB)); }
        _Float16* lf = (_Float16*)(ws + WS_LF); f32x2* rowstat = (f32x2*)(ws + WS_ROWSTAT);
        if (kind == 3) {
            float lb[2][8];
#pragma unroll
            for (int bj = 0; bj < 2; ++bj)
#pragma unroll
                for (int j = 0; j < 8; ++j) { const int c = c0 + bj * 128 + j; lb[bj][j] = fast_sigmoid(lbl[c] - lbl[1024 + c]); }
#pragma unroll
            for (int ai = 0; ai < 2; ++ai)
#pragma unroll
                for (int m = 0; m < 4; ++m) { _Float16* rowp = lf + (size_t)(row0 + ai * 128 + m * 16) * 1024 + c0;
#pragma unroll
                    for (int bj = 0; bj < 2; ++bj) { f32x4 o0, o1;
#pragma unroll
                        for (int j = 0; j < 4; ++j) { o0[j] = fast_log(lb[bj][j] + (1.f - lb[bj][j]) * fast_sigmoid(acc[ai][bj][m][0][j])); o1[j] = fast_log(lb[bj][4 + j] + (1.f - lb[bj][4 + j]) * fast_sigmoid(acc[ai][bj][m][1][j])); }
                        typedef _Float16 h8 __attribute__((ext_vector_type(8))); h8 hv;
#pragma unroll
                        for (int j = 0; j < 4; ++j) { hv[j] = (_Float16)o0[j]; hv[4 + j] = (_Float16)o1[j]; }
                        *(h8*)(rowp + bj * 128) = hv; } }
            return;
        }
#pragma unroll
        for (int ai = 0; ai < 2; ++ai)
#pragma unroll
            for (int m = 0; m < 4; ++m) { const int row = row0 + ai * 128 + m * 16; bf16_t* rowp = base + (size_t)row * ldc + c0; float s1 = 0.f, s2 = 0.f;
#pragma unroll
                for (int bj = 0; bj < 2; ++bj) { f32x4 v0 = acc[ai][bj][m][0], v1 = acc[ai][bj][m][1];
                    if (kind == 0 || kind == 1) {
#pragma unroll
                        for (int j = 0; j < 4; ++j) { v0[j] = fast_gelu(v0[j]); v1[j] = fast_gelu(v1[j]); } }
                    else if (kind == 5) {
#pragma unroll
                        for (int j = 0; j < 4; ++j) { v0[j] = v0[j] * fast_sigmoid(v0[j]); v1[j] = v1[j] * fast_sigmoid(v1[j]); } }
                    else if (kind == 6) {
#pragma unroll
                        for (int j = 0; j < 4; ++j) { v0[j] = fast_sigmoid(v0[j]); v1[j] = fast_sigmoid(v1[j]); } }
                    u32x4 w; w.x = cvt_pk_bf16(v0[0], v0[1]); w.y = cvt_pk_bf16(v0[2], v0[3]); w.z = cvt_pk_bf16(v1[0], v1[1]); w.w = cvt_pk_bf16(v1[2], v1[3]);
                    *(u32x4*)(rowp + bj * 128) = w;
                    if (kind == 1) {
#pragma unroll
                        for (int q = 0; q < 4; ++q) { const float a = bf_lo(w[q]), b = bf_hi(w[q]); s1 += a + b; s2 += a * a + b * b; } }
                }
                if (kind == 1) { s1 += __shfl_xor(s1, 16); s1 += __shfl_xor(s1, 32); s2 += __shfl_xor(s2, 16); s2 += __shfl_xor(s2, 32);
                    if (fq == 0) rowstat[(size_t)row * 16 + (pn & 3) * 4 + wc] = (f32x2){s1, s2}; }
            }
    }
};
struct EpiMerge {
    static constexpr bool PERM = true, HAS_MID = true;
    const bf16_t* sga; const bf16_t* sgb; bf16_t* merged;
    __device__ __forceinline__ void mid(f32x4 (&acc)[2][2][4][2], const pg8::Unit& u, int wr, int wc, int fr, int fq) const {
        int row0 = u.pm * 256 + wr * 64 + fr, c0 = u.pn * 256 + wc * 32 + 8 * fq;
        asm volatile("" : "+v"(row0), "+v"(c0));
#pragma unroll
        for (int ai = 0; ai < 2; ++ai)
#pragma unroll
            for (int m = 0; m < 4; ++m) { const size_t off = (size_t)(row0 + ai * 128 + m * 16) * 2048 + c0;
#pragma unroll
                for (int bj = 0; bj < 2; ++bj) { const u32x4 a8 = *(const u32x4*)(sga + off + bj * 128), b8 = *(const u32x4*)(sgb + off + bj * 128);
#pragma unroll
                    for (int q = 0; q < 4; ++q) { const float rl = bf_lo(a8[q]) * __builtin_amdgcn_rcpf(bf_lo(b8[q])), rh = bf_hi(a8[q]) * __builtin_amdgcn_rcpf(bf_hi(b8[q]));
                        acc[ai][bj][m][q >> 1][(q & 1) * 2] *= rl; acc[ai][bj][m][q >> 1][(q & 1) * 2 + 1] *= rh; } }
                if (m == 3) asm volatile("" ::: "memory"); }
    }
    __device__ __forceinline__ void operator()(const f32x4 (&acc)[2][2][4][2], const pg8::Unit& u, int wr, int wc, int fr, int fq) const {
        const int row0 = u.pm * 256 + wr * 64 + fr, c0 = u.pn * 256 + wc * 32 + 8 * fq;
        u32x4 gb[2][4][2];
#pragma unroll
        for (int ai = 0; ai < 2; ++ai)
#pragma unroll
            for (int m = 0; m < 4; ++m)
#pragma unroll
                for (int bj = 0; bj < 2; ++bj) gb[ai][m][bj] = *(const u32x4*)(sgb + (size_t)(row0 + ai * 128 + m * 16) * 2048 + c0 + bj * 128);
#pragma unroll
        for (int ai = 0; ai < 2; ++ai)
#pragma unroll
            for (int m = 0; m < 4; ++m) { const size_t off = (size_t)(row0 + ai * 128 + m * 16) * 2048 + c0;
#pragma unroll
                for (int bj = 0; bj < 2; ++bj) { const u32x4 b8 = gb[ai][m][bj]; const f32x4 v0 = acc[ai][bj][m][0], v1 = acc[ai][bj][m][1];
                    u32x4 w; w.x = cvt_pk_bf16(v0[0] * bf_lo(b8.x), v0[1] * bf_hi(b8.x)); w.y = cvt_pk_bf16(v0[2] * bf_lo(b8.y), v0[3] * bf_hi(b8.y));
                    w.z = cvt_pk_bf16(v1[0] * bf_lo(b8.z), v1[1] * bf_hi(b8.z)); w.w = cvt_pk_bf16(v1[2] * bf_lo(b8.w), v1[3] * bf_hi(b8.w));
                    *(u32x4*)(merged + off + bj * 128) = w; }
                if (m == 3) asm volatile("" ::: "memory"); }
    }
};
struct EpiRes {
    static constexpr bool PERM = true, HAS_MID = false;
    const float* x; bf16_t* x1b;
    __device__ __forceinline__ void mid(f32x4 (&)[2][2][4][2], const pg8::Unit&, int, int, int, int) const {}
    __device__ __forceinline__ void operator()(const f32x4 (&acc)[2][2][4][2], const pg8::Unit& u, int wr, int wc, int fr, int fq) const {
        const int row0 = u.pm * 256 + wr * 64 + fr, c0 = u.pn * 256 + wc * 32 + 8 * fq;
#pragma unroll
        for (int ai = 0; ai < 2; ++ai) {
            f32x4 xv[4][2][2];
#pragma unroll
            for (int m = 0; m < 4; ++m)
#pragma unroll
                for (int bj = 0; bj < 2; ++bj) { const float* xp = x + (size_t)(row0 + ai * 128 + m * 16) * D + c0 + bj * 128; xv[m][bj][0] = *(const f32x4*)xp; xv[m][bj][1] = *(const f32x4*)(xp + 4); }
#pragma unroll
            for (int m = 0; m < 4; ++m) { const size_t off = (size_t)(row0 + ai * 128 + m * 16) * D + c0;
#pragma unroll
                for (int bj = 0; bj < 2; ++bj) { const f32x4 xa = xv[m][bj][0], xb = xv[m][bj][1];
                    const f32x4 r0 = xa + acc[ai][bj][m][0], r1 = xb + acc[ai][bj][m][1];
                    u32x4 p; p.x = cvt_pk_bf16(r0[0], r0[1]); p.y = cvt_pk_bf16(r0[2], r0[3]); p.z = cvt_pk_bf16(r1[0], r1[1]); p.w = cvt_pk_bf16(r1[2], r1[3]);
                    *(u32x4*)(x1b + off + bj * 128) = p; }
            }
            asm volatile("" ::: "memory"); }
    }
};
#define XB_TMO      128
#define XB_XCNT(j)  (256  + 64 * (j))
#define XB_XSUB(j)  (1280 + 64 * (j))
#define XB_XGEN(j)  (2304 + 64 * (j))
#define XB_TOP      3328
#define XB_TOPGEN   3392
#define XCD_BAR_WORDS 3456
#define XB_SPIN_CAP (1u << 18)
__device__ __forceinline__ unsigned xb_ld(unsigned* p)              { return __hip_atomic_load(p, __ATOMIC_RELAXED, __HIP_MEMORY_SCOPE_AGENT); }
__device__ __forceinline__ unsigned xb_add(unsigned* p, unsigned v) { return __hip_atomic_fetch_add(p, v, __ATOMIC_RELAXED, __HIP_MEMORY_SCOPE_AGENT); }
__device__ __forceinline__ unsigned xb_xcc_id() { return (unsigned)__builtin_amdgcn_s_getreg((3 << 11) | 20) & 0xFu; }
#define XB_SPIN(cond, bar) do { unsigned _sp = 0; while (cond) { __builtin_amdgcn_s_sleep(1); \
    if ((++_sp & 255u) == 0u) { if (xb_ld(&(bar)[XB_TMO])) break; if (_sp > XB_SPIN_CAP) { atomicAdd(&(bar)[XB_TMO], 1u); break; } } } } while (0)
struct XcdBarrier { unsigned* bar; unsigned x; volatile LAS unsigned* st; };
__device__ __forceinline__ XcdBarrier xcd_barrier_post(unsigned* bar, volatile LAS unsigned* st) {
    XcdBarrier b; b.bar = bar; b.x = xb_xcc_id(); b.st = st;
    if (threadIdx.x == 0) (void)xb_add(&bar[XB_XCNT(b.x)], 1u);
    return b;
}
__device__ __forceinline__ void xcd_barrier_complete(unsigned* bar, unsigned x, unsigned& nloc, unsigned& nx) {
    const unsigned G = gridDim.x * gridDim.y * gridDim.z;
    unsigned sum, cnt, mine, sp = 0u;
    for (;;) {
        sum = 0u; cnt = 0u; mine = 0u;
#pragma unroll
        for (unsigned j = 0; j < 16; ++j) { const unsigned c = xb_ld(&bar[XB_XCNT(j)]); sum += c; cnt += (c > 0u) ? 1u : 0u; mine = (j == x) ? c : mine; }
        if (sum == G) break;
        __builtin_amdgcn_s_sleep(1);
        if ((++sp & 255u) == 0u) { if (xb_ld(&bar[XB_TMO])) break; if (sp > XB_SPIN_CAP) { atomicAdd(&bar[XB_TMO], 1u); break; } }
    }
    nloc = mine > 0u ? mine : 1u; nx = cnt > 0u ? cnt : 1u;
}
__device__ __forceinline__ void xcd_barrier(const XcdBarrier& b) {
    asm volatile("s_waitcnt vmcnt(0)" ::: "memory");
    __syncthreads();
    if (threadIdx.x == 0) {
        unsigned* bar = b.bar;
        __builtin_amdgcn_s_waitcnt(0);
        unsigned nloc = b.st[0], nx = b.st[1];
        if (nloc == 0u) { xcd_barrier_complete(bar, b.x, nloc, nx); b.st[0] = nloc; b.st[1] = nx; }
        const unsigned old = xb_add(&bar[XB_XSUB(b.x)], 1u);
        const unsigned gen = old / nloc;
        if (old + 1u == (gen + 1u) * nloc) {
            __builtin_amdgcn_fence(__ATOMIC_RELEASE, "agent");
            asm volatile("s_waitcnt vmcnt(0)" ::: "memory");
            const unsigned og = xb_add(&bar[XB_TOP], 1u);
            const unsigned tg = og / nx;
            if (og + 1u == (tg + 1u) * nx) xb_add(&bar[XB_TOPGEN], 1u);
            else XB_SPIN(xb_ld(&bar[XB_TOPGEN]) == tg, bar);
            __builtin_amdgcn_fence(__ATOMIC_ACQUIRE, "agent");
            xb_add(&bar[XB_XGEN(b.x)], 1u);
            asm volatile("s_waitcnt vmcnt(0)" ::: "memory");
        } else {
            XB_SPIN(xb_ld(&bar[XB_XGEN(b.x)]) == gen, bar);
            __builtin_amdgcn_fence(__ATOMIC_ACQUIRE, "agent");
            asm volatile("s_waitcnt vmcnt(0)" ::: "memory");
        }
    }
    __syncthreads();
}

struct Args { const float* in[21]; float* out; unsigned char* ws; int ph_lo, ph_hi; };
struct Frame {
    LAS unsigned char* lds; volatile LAS unsigned* MISC;
    int tid, lane, wave, G, bid;
    const Args* a; unsigned char* ws;
};
#define LDS_WAIT() asm volatile("s_waitcnt lgkmcnt(0)" ::: "memory")

__device__ __forceinline__ void tr_load(f32x4 (&v)[8], const float* src, int ld_src, int lane) {
    const int kr = lane >> 3, nc = (lane & 7) * 4;
#pragma unroll
    for (int i = 0; i < 8; ++i) v[i] = *(const f32x4*)(src + (size_t)(8 * i + kr) * ld_src + nc);
}
__device__ __forceinline__ void tr_store(const f32x4 (&v)[8], bf16_t* dst, int ld_dst, LAS float* scr, int lane) {
    const int kr = lane >> 3, nc = (lane & 7) * 4;
#pragma unroll
    for (int i = 0; i < 8; ++i) { LAS float* s = scr + (8 * i + kr) * 33 + nc; s[0] = v[i][0]; s[1] = v[i][1]; s[2] = v[i][2]; s[3] = v[i][3]; }
    LDS_WAIT();
    const int c = lane & 7, nl = lane >> 3;
#pragma unroll
    for (int j = 0; j < 4; ++j) { const int n = nl + 8 * j; const LAS float* s = scr + (8 * c) * 33 + n;
        u32x4 o; o.x = cvt_pk_bf16(s[0 * 33], s[1 * 33]); o.y = cvt_pk_bf16(s[2 * 33], s[3 * 33]); o.z = cvt_pk_bf16(s[4 * 33], s[5 * 33]); o.w = cvt_pk_bf16(s[6 * 33], s[7 * 33]);
        *(u32x4*)(dst + (size_t)n * ld_dst + 8 * c) = o; }
    LDS_WAIT();
}
struct TrJob { const float* src; bf16_t* dst; int ld_src, ld_dst; };
__device__ __forceinline__ TrJob tr_job(const Frame& F, int it) {
    const Args& a = *F.a; unsigned char* ws = F.ws; TrJob j;
    constexpr int I_IN = (D / 64) * (NZ / 32);
    constexpr int I_PA = (GW / 64) * (D / 32);
    constexpr int I_OUT = (D / 64) * (D / 32);
    constexpr int I_EG = (D / 64) * (DE / 32);
    constexpr int I_ED = (DE / 64) * (D / 32);
    if (it < I_IN) { const int kb = it / (NZ / 32), nb = it % (NZ / 32); j.src = a.in[2] + (size_t)(64 * kb) * NZ + 32 * nb; j.ld_src = NZ; j.dst = (bf16_t*)(ws + WS_WTIN) + (size_t)(32 * nb) * D + 64 * kb; j.ld_dst = D; return j; } it -= I_IN;
    if (it < I_PA) { const int kb = it / (D / 32), nb = it % (D / 32); j.src = a.in[9] + (size_t)(64 * kb) * D + 32 * nb; j.ld_src = D; j.dst = (bf16_t*)(ws + WS_WTPAB) + (size_t)(32 * nb) * 2048 + 64 * kb; j.ld_dst = 2048; return j; } it -= I_PA;
    if (it < I_PA) { const int kb = it / (D / 32), nb = it % (D / 32); j.src = a.in[10] + (size_t)(64 * kb) * D + 32 * nb; j.ld_src = D; j.dst = (bf16_t*)(ws + WS_WTPAB) + (size_t)(32 * nb) * 2048 + 1024 + 64 * kb; j.ld_dst = 2048; return j; } it -= I_PA;
    if (it < I_OUT) { const int kb = it / (D / 32), nb = it % (D / 32); j.src = a.in[11] + (size_t)(64 * kb) * D + 32 * nb; j.ld_src = D; j.dst = (bf16_t*)(ws + WS_WTOUT) + (size_t)(32 * nb) * D + 64 * kb; j.ld_dst = D; return j; } it -= I_OUT;
    const int e = it / (2 * I_EG + I_ED); int r = it % (2 * I_EG + I_ED);
    if (r < 2 * I_EG) { const int up = r >= I_EG; if (up) r -= I_EG; const int kb = r / (DE / 32), nb = r % (DE / 32); const int n0 = 32 * nb;
        j.src = (up ? a.in[18] : a.in[17]) + (size_t)e * D * DE + (size_t)(64 * kb) * DE + n0; j.ld_src = DE;
        j.dst = (bf16_t*)(ws + WS_WGU) + ((size_t)e * 2048 + (n0 >> 7) * 256 + (n0 & 127) + (up ? 128 : 0)) * 2048 + 64 * kb; j.ld_dst = 2048; return j; }
    r -= 2 * I_EG; { const int kb = r / (D / 32), nb = r % (D / 32);
        j.src = a.in[19] + (size_t)e * DE * D + (size_t)(64 * kb) * D + 32 * nb; j.ld_src = D;
        j.dst = (bf16_t*)(ws + WS_WD) + ((size_t)e * 2048 + 32 * nb) * 1024 + 64 * kb; j.ld_dst = 1024; return j; }
}
constexpr int TR_ITEMS_SMALL = (D / 64) * (NZ / 32) + 2 * (GW / 64) * (D / 32) + (D / 64) * (D / 32);
constexpr int TR_ITEMS_ALL = TR_ITEMS_SMALL + NE * 3 * 1024;

__device__ __forceinline__ void rms_row_to_bf16(const float* xrow, const f32x4 (&gg8)[8], bf16_t* orow, int lane) {
    const f32x4* xr = (const f32x4*)xrow + lane;
    f32x4 v[8]; float s = 0.f;
#pragma unroll
    for (int j = 0; j < 8; ++j) { v[j] = xr[64 * j]; s += (v[j][0] * v[j][0] + v[j][1] * v[j][1]) + (v[j][2] * v[j][2] + v[j][3] * v[j][3]); }
    const float r = rsqrtf(wave_sum(s) * (1.f / D) + EPS);
    u32x2* o8 = (u32x2*)orow + lane;
#pragma unroll
    for (int j = 0; j < 8; ++j) { const f32x4 gg = gg8[j]; u32x2 w; w.x = cvt_pk_bf16(v[j][0] * r * gg[0], v[j][1] * r * gg[1]); w.y = cvt_pk_bf16(v[j][2] * r * gg[2], v[j][3] * r * gg[3]); o8[64 * j] = w; }
}
__device__ __forceinline__ void p0_prologue(Frame& F, int n_items) {
    LAS float* scr = (LAS float*)(F.lds + F.wave * 8448);
    const int gw = F.bid * NWAVES + F.wave, NGW = F.G * NWAVES;
    f32x4 va[8], vb[8];
    int it = gw;
    TrJob ja, jb;
    if (it < n_items) { ja = tr_job(F, it); tr_load(va, ja.src, ja.ld_src, F.lane); }
    while (it < n_items) {
        const int itb = it + NGW;
        if (itb < n_items) { jb = tr_job(F, itb); tr_load(vb, jb.src, jb.ld_src, F.lane); }
        tr_store(va, ja.dst, ja.ld_dst, scr, F.lane);
        const int itc = itb + NGW;
        if (itc < n_items) { ja = tr_job(F, itc); tr_load(va, ja.src, ja.ld_src, F.lane); }
        if (itb < n_items) tr_store(vb, jb.dst, jb.ld_dst, scr, F.lane);
        it = itc;
    }
    f32x4 gg8[8];
#pragma unroll
    for (int j = 0; j < 8; ++j) gg8[j] = ((const f32x4*)F.a->in[1])[F.lane + 64 * j];
    for (int m = gw; m < T; m += 4 * NGW) {
        const int lane = F.lane; f32x4 v[4][8]; float ss[4];
#pragma unroll
        for (int q = 0; q < 4; ++q) { const int mq = m + q * NGW < T ? m + q * NGW : m; const f32x4* xr = (const f32x4*)(F.a->in[0] + (size_t)mq * D) + lane;
#pragma unroll
            for (int j = 0; j < 8; ++j) v[q][j] = xr[64 * j]; }
#pragma unroll
        for (int q = 0; q < 4; ++q) { float t = 0.f;
#pragma unroll
            for (int j = 0; j < 8; ++j) t += (v[q][j][0] * v[q][j][0] + v[q][j][1] * v[q][j][1]) + (v[q][j][2] * v[q][j][2] + v[q][j][3] * v[q][j][3]);
            ss[q] = rsqrtf(wave_sum(t) * (1.f / D) + EPS); }
#pragma unroll
        for (int q = 0; q < 4; ++q) { const int mq = m + q * NGW; if (mq < T) { u32x2* o8 = (u32x2*)((bf16_t*)(F.ws + WS_H) + (size_t)mq * D) + lane; const float r = ss[q];
#pragma unroll
            for (int j = 0; j < 8; ++j) { const f32x4 gg = gg8[j]; u32x2 w; w.x = cvt_pk_bf16(v[q][j][0] * r * gg[0], v[q][j][1] * r * gg[1]); w.y = cvt_pk_bf16(v[q][j][2] * r * gg[2], v[q][j][3] * r * gg[3]); o8[64 * j] = w; } } }
    }
}
__device__ __forceinline__ f32x4 mfma16(bf16x8 a, bf16x8 b, f32x4 c) { return __builtin_amdgcn_mfma_f32_16x16x32_bf16(a, b, c, 0, 0, 0); }
constexpr int TP = 272;
constexpr int AP = 528;

template <class XF>
__device__ __forceinline__ void build_transposed(LAS unsigned char* dstT, const bf16_t* src, int ld, int tid, const XF& xf) {
#pragma unroll
    for (int it = 0; it < 2; ++it) {
        const int bi = tid + 512 * it, sb = bi >> 5, db = bi & 31, s0 = 4 * sb, d0 = 4 * db;
        u32x2 r[4];
#pragma unroll
        for (int q = 0; q < 4; ++q) r[q] = *(const u32x2*)(src + (size_t)(s0 + q) * ld + d0);
        float v[4][4];
#pragma unroll
        for (int q = 0; q < 4; ++q) { v[q][0] = xf(bf_lo(r[q].x), s0 + q, d0); v[q][1] = xf(bf_hi(r[q].x), s0 + q, d0 + 1); v[q][2] = xf(bf_lo(r[q].y), s0 + q, d0 + 2); v[q][3] = xf(bf_hi(r[q].y), s0 + q, d0 + 3); }
#pragma unroll
        for (int i = 0; i < 4; ++i) { u32x2 w; w.x = cvt_pk_bf16(v[0][i], v[1][i]); w.y = cvt_pk_bf16(v[2][i], v[3][i]); *(LAS u32x2*)(dstT + (d0 + i) * TP + s0 * 2) = w; }
    }
}

__device__ __forceinline__ void tile_fetch_bf16(u32x2 (&r)[2][4], const bf16_t* src, int ld, int tid) {
#pragma unroll
    for (int it = 0; it < 2; ++it) { const int bi = tid + 512 * it, s0 = 4 * (bi >> 5), d0 = 4 * (bi & 31);
#pragma unroll
        for (int q = 0; q < 4; ++q) r[it][q] = *(const u32x2*)(src + (size_t)(s0 + q) * ld + d0); }
}
template <class XF>
__device__ __forceinline__ void build_transposed_regs(LAS unsigned char* dstT, const u32x2 (&r)[2][4], int tid, const XF& xf) {
#pragma unroll
    for (int it = 0; it < 2; ++it) { const int bi = tid + 512 * it, s0 = 4 * (bi >> 5), d0 = 4 * (bi & 31);
        float v[4][4];
#pragma unroll
        for (int q = 0; q < 4; ++q) { v[q][0] = xf(bf_lo(r[it][q].x), s0 + q, d0); v[q][1] = xf(bf_hi(r[it][q].x), s0 + q, d0 + 1); v[q][2] = xf(bf_lo(r[it][q].y), s0 + q, d0 + 2); v[q][3] = xf(bf_hi(r[it][q].y), s0 + q, d0 + 3); }
#pragma unroll
        for (int i = 0; i < 4; ++i) { u32x2 w; w.x = cvt_pk_bf16(v[0][i], v[1][i]); w.y = cvt_pk_bf16(v[2][i], v[3][i]); *(LAS u32x2*)(dstT + (d0 + i) * TP + s0 * 2) = w; }
    }
}

__device__ __forceinline__ void gmlp_phase(Frame& F) {
    const Args& a = *F.a; unsigned char* ws = F.ws;
    LAS unsigned char* Wb = F.lds;
    LAS unsigned char* vT = F.lds + 128 * TP;
    LAS float* st_mu = (LAS float*)(F.lds + 2 * 128 * TP);
    LAS float* st_rs = st_mu + 128;
    LAS float* lng = st_rs + 128; LAS float* lnb = lng + 128;
    const int tid = F.tid, lane = F.lane, w = F.wave, g4 = lane >> 4, l15 = lane & 15;
    const bf16_t* gu = (const bf16_t*)(ws + WS_GU); const bf16_t* gv = (const bf16_t*)(ws + WS_GV); const f32x2* rowstat = (const f32x2*)(ws + WS_ROWSTAT);
    bf16_t* yab = (bf16_t*)(ws + WS_YAB);
    int cur_g = -1;
    for (int u = F.bid; u < 1024; u += F.G) {
        const int c = u >> 3, g = u & 7, t0 = c * 128;
        __syncthreads();
        u32x2 rv_[2][4], ru[8];
        tile_fetch_bf16(rv_, gv + (size_t)t0 * GW + g * 128, GW, tid);
#pragma unroll
        for (int db = 0; db < 8; ++db) ru[db] = *(const u32x2*)(gu + (size_t)(t0 + 16 * w + l15) * GW + g * 128 + 16 * db + 4 * g4);
        if (g != cur_g) {
            cur_g = g;
            const int t = tid >> 2, sq = (tid & 3) * 32; const float* wr = a.in[5] + ((size_t)g * 128 + t) * 128 + sq;
#pragma unroll
            for (int q = 0; q < 4; ++q) { const f32x4 x0 = *(const f32x4*)(wr + 8 * q), x1 = *(const f32x4*)(wr + 8 * q + 4); const int s = sq + 8 * q;
                u32x4 o; o.x = cvt_pk_bf16(s + 0 <= t ? x0[0] : 0.f, s + 1 <= t ? x0[1] : 0.f); o.y = cvt_pk_bf16(s + 2 <= t ? x0[2] : 0.f, s + 3 <= t ? x0[3] : 0.f);
                o.z = cvt_pk_bf16(s + 4 <= t ? x1[0] : 0.f, s + 5 <= t ? x1[1] : 0.f); o.w = cvt_pk_bf16(s + 6 <= t ? x1[2] : 0.f, s + 7 <= t ? x1[3] : 0.f);
                *(LAS u32x4*)(Wb + t * TP + s * 2) = o; }
            if (tid < 128) { lng[tid] = a.in[3][g * 128 + tid]; lnb[tid] = a.in[4][g * 128 + tid]; }
        }
        if (tid < 128) { float s1 = 0.f, s2 = 0.f;
#pragma unroll
            for (int i = 0; i < 16; ++i) { const f32x2 p = rowstat[(size_t)(t0 + tid) * 16 + i]; s1 += p[0]; s2 += p[1]; }
            const float mu = s1 * (1.f / GW), var = s2 * (1.f / GW) - mu * mu; st_mu[tid] = mu; st_rs[tid] = rsqrtf(var + EPS); }
        __syncthreads();
        build_transposed_regs(vT, rv_, tid, [&](float x, int s, int d) { return (x - st_mu[s]) * st_rs[s] * lng[d] + lnb[d]; });
        __syncthreads();
        f32x4 acc[8];
#pragma unroll
        for (int db = 0; db < 8; ++db) acc[db] = (f32x4){0.f, 0.f, 0.f, 0.f};
        const int nks = ((16 * w + 15) >> 5) + 1;
        for (int ks = 0; ks < nks; ++ks) {
            const bf16x8 bw = *(const LAS bf16x8*)(Wb + (16 * w + l15) * TP + (32 * ks + 8 * g4) * 2);
#pragma unroll
            for (int db = 0; db < 8; ++db) { const bf16x8 av = *(const LAS bf16x8*)(vT + (16 * db + l15) * TP + (32 * ks + 8 * g4) * 2); acc[db] = mfma16(av, bw, acc[db]); }
        }
        const int tl = 16 * w + l15; const float bias = a.in[6][g * 128 + tl];
        const size_t rowoff = (size_t)(t0 + tl);
#pragma unroll
        for (int db = 0; db < 8; ++db) { const int d = 16 * db + 4 * g4; const u32x2 uu = ru[db];
            u32x2 o; o.x = cvt_pk_bf16(bf_lo(uu.x) * (acc[db][0] + bias), bf_hi(uu.x) * (acc[db][1] + bias)); o.y = cvt_pk_bf16(bf_lo(uu.y) * (acc[db][2] + bias), bf_hi(uu.y) * (acc[db][3] + bias));
            *(u32x2*)(yab + rowoff * 2048 + g * 128 + d) = o; }
    }
    __syncthreads();
}
constexpr int H_A = 0, H_T1 = 128 * AP  , H_T2 = H_T1 + 128 * TP  , H_TOT = H_T2 + 128 * TP  ;

typedef _Float16 lfh4 __attribute__((ext_vector_type(4)));
__device__ __forceinline__ void hgrn_tile_fetch(lfh4 (&pf)[8], const _Float16* lf, int tid) {
#pragma unroll
    for (int it = 0; it < 8; ++it) { const int s = (tid >> 5) + 16 * it, col = (tid & 31) * 4; pf[it] = *(const lfh4*)(lf + (size_t)s * GW + col); }
}
template <bool FROM_REGS>
__device__ __forceinline__ void hgrn_load_scan(LAS unsigned char* A, LAS float* tot, const _Float16* lf, int tid, const lfh4 (&pf)[8]) {
#pragma unroll
    for (int it = 0; it < 8; ++it) { const int s = (tid >> 5) + 16 * it, col = (tid & 31) * 4; const lfh4 hv = FROM_REGS ? pf[it] : *(const lfh4*)(lf + (size_t)s * GW + col);
        *(LAS f32x4*)(A + s * AP + col * 4) = (f32x4){(float)hv[0], (float)hv[1], (float)hv[2], (float)hv[3]}; }
    __syncthreads();
    const int k = tid & 127, seg = tid >> 7;
    LAS float* colp = (LAS float*)(A + (32 * seg) * AP) + k;
    float cv[32];
#pragma unroll
    for (int r = 0; r < 32; ++r) cv[r] = colp[r * (AP / 4)];
    float run = 0.f;
#pragma unroll
    for (int r = 0; r < 32; ++r) { run += cv[r]; cv[r] = run; }
    tot[seg * 128 + k] = run;
    __syncthreads();
    float off = 0.f;
#pragma unroll
    for (int s2 = 0; s2 < 3; ++s2) if (s2 < seg) off += tot[s2 * 128 + k];
#pragma unroll
    for (int r = 0; r < 32; ++r) colp[r * (AP / 4)] = cv[r] + off;
    __syncthreads();
}

__device__ __forceinline__ void hgrn_h1_phase(Frame& F) {
    unsigned char* ws = F.ws;
    LAS unsigned char* A = F.lds + H_A; LAS unsigned char* kdT = F.lds + H_T1; LAS unsigned char* iT = F.lds + H_T2; LAS float* tot = (LAS float*)(F.lds + H_TOT);
    const int tid = F.tid, lane = F.lane, w = F.wave, g4 = lane >> 4, l15 = lane & 15;
    const _Float16* lf = (const _Float16*)(ws + WS_LF); const bf16_t* ib = (const bf16_t*)(ws + WS_IB);
    float* Hbuf = (float*)(ws + WS_HBUF); float* Dc = (float*)(ws + WS_DC);
    for (int u = F.bid; u < 1024; u += F.G) {
        const int c = u >> 3, h = u & 7, t0 = c * 128;
        __syncthreads();
        u32x2 ri[2][4]; lfh4 pf[8];
        hgrn_tile_fetch(pf, lf + (size_t)t0 * GW + h * 128, tid); tile_fetch_bf16(ri, ib + (size_t)t0 * GW + h * 128, GW, tid);
        hgrn_load_scan<true>(A, tot, lf, tid, pf);
#pragma unroll
        for (int it = 0; it < 2; ++it) {
            const int bi = tid + 512 * it, sb = bi >> 5, k0 = 4 * (bi & 31), s0 = 4 * sb;
            const f32x4 aend = *(const LAS f32x4*)(A + 127 * AP + k0 * 4);
            f32x4 prev = (f32x4){0.f, 0.f, 0.f, 0.f}; if (s0 > 0) prev = *(const LAS f32x4*)(A + (s0 - 1) * AP + k0 * 4);
            float v[4][4];
#pragma unroll
            for (int q = 0; q < 4; ++q) { const f32x4 cur = *(const LAS f32x4*)(A + (s0 + q) * AP + k0 * 4);
#pragma unroll
                for (int i = 0; i < 4; ++i) v[q][i] = (1.f - fast_exp(cur[i] - prev[i])) * fast_exp(aend[i] - cur[i]);
                prev = cur; }
#pragma unroll
            for (int i = 0; i < 4; ++i) { u32x2 o; o.x = cvt_pk_bf16(v[0][i], v[1][i]); o.y = cvt_pk_bf16(v[2][i], v[3][i]); *(LAS u32x2*)(kdT + (k0 + i) * TP + s0 * 2) = o; }
        }
        build_transposed_regs(iT, ri, tid, [](float x, int, int) { return x; });
        if (tid < 128) Dc[(size_t)(c * 8 + h) * 128 + tid] = fast_exp(*(const LAS float*)(A + 127 * AP + tid * 4));
        __syncthreads();
        f32x4 acc[8];
#pragma unroll
        for (int kb = 0; kb < 8; ++kb) acc[kb] = (f32x4){0.f, 0.f, 0.f, 0.f};
#pragma unroll
        for (int ks = 0; ks < 4; ++ks) { const bf16x8 ai = *(const LAS bf16x8*)(iT + (16 * w + l15) * TP + (32 * ks + 8 * g4) * 2);
#pragma unroll
            for (int kb = 0; kb < 8; ++kb) { const bf16x8 bk = *(const LAS bf16x8*)(kdT + (16 * kb + l15) * TP + (32 * ks + 8 * g4) * 2); acc[kb] = mfma16(ai, bk, acc[kb]); } }
        float* hb = Hbuf + ((size_t)(c * 8 + h) * 128 + 16 * w + 4 * g4) * 128 + l15;
#pragma unroll
        for (int kb = 0; kb < 8; ++kb)
#pragma unroll
            for (int r = 0; r < 4; ++r) hb[r * 128 + 16 * kb] = acc[kb][r];
    }
    __syncthreads();
}

__device__ __forceinline__ void hgrn_h2_phase(Frame& F) {
    unsigned char* ws = F.ws;
    const float* __restrict__ Hbuf = (const float*)(ws + WS_HBUF); const float* __restrict__ Dc = (const float*)(ws + WS_DC); bf16_t* __restrict__ Sbuf = (bf16_t*)(ws + WS_SBUF);
    for (int e = F.bid * NTHR + F.tid; e < 8 * 128 * 128; e += F.G * NTHR) {
        const int h = e >> 14, vk = e & 16383, k = e & 127;
        const float* hp = Hbuf + (size_t)h * 16384 + vk; bf16_t* sp = Sbuf + (size_t)h * 16384 + vk; const float* dp = Dc + h * 128 + k;
        float S = 0.f;
        for (int c0 = 0; c0 < 128; c0 += 32) {
            float hv[32], dv[32];
#pragma unroll
            for (int j = 0; j < 32; ++j) { hv[j] = hp[(size_t)(c0 + j) * 131072]; dv[j] = dp[(c0 + j) * 1024]; }
#pragma unroll
            for (int j = 0; j < 32; ++j) { sp[(size_t)(c0 + j) * 131072] = (bf16_t)(cvt_pk_bf16(S, 0.f) & 0xffffu); S = dv[j] * S + hv[j]; }
        }
    }
}

__device__ __forceinline__ void hgrn_h3_phase(Frame& F) {
    const Args& a_ = *F.a; unsigned char* ws = F.ws;
    LAS unsigned char* A = F.lds + H_A;
    LAS unsigned char* iT = F.lds + H_T1; LAS unsigned char* ST = F.lds + H_T2; LAS float* tot = (LAS float*)(F.lds + H_TOT);
    LAS float* Gt = (LAS float*)(F.lds + H_TOT + 2048);
    const int tid = F.tid, lane = F.lane, w = F.wave, g4 = lane >> 4, l15 = lane & 15;
    const _Float16* lf = (const _Float16*)(ws + WS_LF); const bf16_t* ib = (const bf16_t*)(ws + WS_IB); const bf16_t* qb = (const bf16_t*)(ws + WS_QB); const bf16_t* sg = (const bf16_t*)(ws + WS_SG);
    const bf16_t* Sbuf = (const bf16_t*)(ws + WS_SBUF); bf16_t* yab = (bf16_t*)(ws + WS_YAB); const float* ng = a_.in[8];
    const f32x4 z4 = (f32x4){0.f, 0.f, 0.f, 0.f};
    for (int u = F.bid; u < 1024; u += F.G) {
        const int c = u >> 3, h = u & 7, t0 = c * 128;
        const int a = w, t = 16 * a + l15;
        __syncthreads();
        lfh4 pf[8]; u32x2 ri[2][4]; u32x4 rS[4], rq[4]; u32x2 rsg[8];
        hgrn_tile_fetch(pf, lf + (size_t)t0 * GW + h * 128, tid);
#pragma unroll
        for (int it = 0; it < 2; ++it) { const int bi = tid + 512 * it, s0 = 4 * (bi >> 5), d0 = 4 * (bi & 31);
#pragma unroll
            for (int q = 0; q < 4; ++q) ri[it][q] = *(const u32x2*)(ib + (size_t)(t0 + s0 + q) * GW + h * 128 + d0); }
#pragma unroll
        for (int it = 0; it < 4; ++it) { const int ci = tid + 512 * it, v = ci >> 4, ch = ci & 15; rS[it] = *(const u32x4*)(Sbuf + ((size_t)(c * 8 + h) * 128 + v) * 128 + ch * 8); }
#pragma unroll
        for (int ks = 0; ks < 4; ++ks) rq[ks] = *(const u32x4*)(qb + (size_t)(t0 + t) * GW + h * 128 + 32 * ks + 8 * g4);
        hgrn_load_scan<true>(A, tot, lf, tid, pf);
#pragma unroll
        for (int it = 0; it < 2; ++it) { const int bi = tid + 512 * it, s0 = 4 * (bi >> 5), d0 = 4 * (bi & 31);
#pragma unroll
            for (int i = 0; i < 4; ++i) { const unsigned a0 = (i & 2) ? ri[it][0].y : ri[it][0].x, a1 = (i & 2) ? ri[it][1].y : ri[it][1].x, a2 = (i & 2) ? ri[it][2].y : ri[it][2].x, a3 = (i & 2) ? ri[it][3].y : ri[it][3].x;
                u32x2 wv; if (i & 1) { wv.x = (a0 >> 16) | (a1 & 0xffff0000u); wv.y = (a2 >> 16) | (a3 & 0xffff0000u); } else { wv.x = (a0 & 0xffffu) | (a1 << 16); wv.y = (a2 & 0xffffu) | (a3 << 16); }
                *(LAS u32x2*)(iT + (d0 + i) * TP + s0 * 2) = wv; } }
#pragma unroll
        for (int it = 0; it < 4; ++it) { const int ci = tid + 512 * it, v = ci >> 4, ch = ci & 15; *(LAS u32x4*)(ST + v * TP + ch * 16) = rS[it]; }
        u32x4 kdv[4];
        { const int s_ = tid >> 2, kb = 32 * (tid & 3), se = (s_ | 15);
#pragma unroll
          for (int c8 = 0; c8 < 4; ++c8) { const int k0 = kb + 8 * c8;
              const f32x4 c0 = *(const LAS f32x4*)(A + s_ * AP + k0 * 4), c1 = *(const LAS f32x4*)(A + s_ * AP + k0 * 4 + 16);
              f32x4 p0 = z4, p1 = z4; if (s_ > 0) { p0 = *(const LAS f32x4*)(A + (s_ - 1) * AP + k0 * 4); p1 = *(const LAS f32x4*)(A + (s_ - 1) * AP + k0 * 4 + 16); }
              const f32x4 e0 = *(const LAS f32x4*)(A + se * AP + k0 * 4), e1 = *(const LAS f32x4*)(A + se * AP + k0 * 4 + 16);
              float kv[8];
#pragma unroll
              for (int j = 0; j < 4; ++j) { kv[j] = (1.f - fast_exp(c0[j] - p0[j])) * fast_exp(e0[j] - c0[j]); kv[4 + j] = (1.f - fast_exp(c1[j] - p1[j])) * fast_exp(e1[j] - c1[j]); }
              kdv[c8].x = cvt_pk_bf16(kv[0], kv[1]); kdv[c8].y = cvt_pk_bf16(kv[2], kv[3]); kdv[c8].z = cvt_pk_bf16(kv[4], kv[5]); kdv[c8].w = cvt_pk_bf16(kv[6], kv[7]); } }
        float gv[2];
#pragma unroll
        for (int r = 0; r < 2; ++r) { const int idx = tid + 512 * r, j = idx >> 7, k = idx & 127; const float hi = *(const LAS float*)(A + (16 * j + 15) * AP + k * 4); const float lo = j > 0 ? *(const LAS float*)(A + (16 * j - 1) * AP + k * 4) : 0.f; gv[r] = fast_exp(hi - lo); }
        bf16x8 qd[4]; float qh[4][8];
#pragma unroll
        for (int ks = 0; ks < 4; ++ks) { const int k0 = 32 * ks + 8 * g4; const u32x4 qr = rq[ks];
            const f32x4 A0 = *(const LAS f32x4*)(A + t * AP + k0 * 4), A1 = *(const LAS f32x4*)(A + t * AP + k0 * 4 + 16);
            const f32x4 E0 = *(const LAS f32x4*)(A + (16 * a + 15) * AP + k0 * 4), E1 = *(const LAS f32x4*)(A + (16 * a + 15) * AP + k0 * 4 + 16);
            const float qv[8] = {bf_lo(qr.x), bf_hi(qr.x), bf_lo(qr.y), bf_hi(qr.y), bf_lo(qr.z), bf_hi(qr.z), bf_lo(qr.w), bf_hi(qr.w)};
            float d[8];
#pragma unroll
            for (int j = 0; j < 4; ++j) { d[j] = qv[j] * fast_exp(A0[j]); d[4 + j] = qv[4 + j] * fast_exp(A1[j]); qh[ks][j] = qv[j] * fast_exp(A0[j] - E0[j]); qh[ks][4 + j] = qv[4 + j] * fast_exp(A1[j] - E1[j]); }
            u32x4 pd; pd.x = cvt_pk_bf16_m(d[0], d[1]); pd.y = cvt_pk_bf16_m(d[2], d[3]); pd.z = cvt_pk_bf16_m(d[4], d[5]); pd.w = cvt_pk_bf16_m(d[6], d[7]);
            qd[ks] = __builtin_bit_cast(bf16x8, pd); }
        __syncthreads();
        { const int s_ = tid >> 2, kb = 32 * (tid & 3);
#pragma unroll
          for (int c8 = 0; c8 < 4; ++c8) *(LAS u32x4*)(A + s_ * TP + (kb + 8 * c8) * 2) = kdv[c8];
#pragma unroll
          for (int r = 0; r < 2; ++r) Gt[tid + 512 * r] = gv[r]; }
        __syncthreads();
#pragma unroll
        for (int vb = 0; vb < 8; ++vb) rsg[vb] = *(const u32x2*)(sg + (size_t)(t0 + t) * GW + h * 128 + 16 * vb + 4 * g4);
        f32x4 acc[8];
#pragma unroll
        for (int vb = 0; vb < 8; ++vb) acc[vb] = z4;
#pragma unroll
        for (int ks = 0; ks < 4; ++ks)
#pragma unroll
            for (int vb = 0; vb < 8; ++vb) { const bf16x8 as = *(const LAS bf16x8*)(ST + (16 * vb + l15) * TP + (32 * ks + 8 * g4) * 2); acc[vb] = mfma16(as, qd[ks], acc[vb]); }
        for (int bp = a; bp >= 0; bp -= 2) {
            u32x2 pk[2]; pk[0] = (u32x2){0u, 0u}; pk[1] = (u32x2){0u, 0u};
#pragma unroll
            for (int half = 0; half < 2; ++half) { const int b = bp - half;
                if (b >= 0) {
                    f32x4 pt = z4;
#pragma unroll
                    for (int ks = 0; ks < 4; ++ks) { const int k0 = 32 * ks + 8 * g4;
                        u32x4 qq; qq.x = cvt_pk_bf16_m(qh[ks][0], qh[ks][1]); qq.y = cvt_pk_bf16_m(qh[ks][2], qh[ks][3]); qq.z = cvt_pk_bf16_m(qh[ks][4], qh[ks][5]); qq.w = cvt_pk_bf16_m(qh[ks][6], qh[ks][7]);
                        const bf16x8 kd = *(const LAS bf16x8*)(A + (16 * b + l15) * TP + k0 * 2);
                        pt = mfma16(kd, __builtin_bit_cast(bf16x8, qq), pt);
                        const f32x4 G0 = *(const LAS f32x4*)(Gt + b * 128 + k0), G1 = *(const LAS f32x4*)(Gt + b * 128 + k0 + 4);
#pragma unroll
                        for (int j = 0; j < 4; ++j) { qh[ks][j] *= G0[j]; qh[ks][4 + j] *= G1[j]; } }
                    if (b == a) {
#pragma unroll
                        for (int r = 0; r < 4; ++r) if (4 * g4 + r > l15) pt[r] = 0.f; }
                    pk[half].x = cvt_pk_bf16_d(pt[0], pt[1]); pk[half].y = cvt_pk_bf16_m(pt[2], pt[3]);
                }
            }
            const int b1 = (bp - 1 >= 0) ? bp - 1 : bp;
            u32x4 bp4; bp4.x = pk[0].x; bp4.y = pk[0].y; bp4.z = pk[1].x; bp4.w = pk[1].y;
            const bf16x8 bP = __builtin_bit_cast(bf16x8, bp4);
#pragma unroll
            for (int vb = 0; vb < 8; ++vb) { const u32x2 lo = *(const LAS u32x2*)(iT + (16 * vb + l15) * TP + (16 * bp + 4 * g4) * 2), hi = *(const LAS u32x2*)(iT + (16 * vb + l15) * TP + (16 * b1 + 4 * g4) * 2);
                u32x4 ai; ai.x = lo.x; ai.y = lo.y; ai.z = hi.x; ai.w = hi.y; acc[vb] = mfma16(__builtin_bit_cast(bf16x8, ai), bP, acc[vb]); }
        }
        float ssq = 0.f;
#pragma unroll
        for (int vb = 0; vb < 8; ++vb) ssq += (acc[vb][0] * acc[vb][0] + acc[vb][1] * acc[vb][1]) + (acc[vb][2] * acc[vb][2] + acc[vb][3] * acc[vb][3]);
        ssq += __shfl_xor(ssq, 16); ssq += __shfl_xor(ssq, 32);
        const float rstd = rsqrtf(ssq * (1.f / 128.f) + EPS);
        f32x4 ngv[8];
#pragma unroll
        for (int vb = 0; vb < 8; ++vb) ngv[vb] = *(const f32x4*)(ng + h * 128 + 16 * vb + 4 * g4);
#pragma unroll
        for (int vb = 0; vb < 8; ++vb) { const int v = 16 * vb + 4 * g4; const f32x4 g4v = ngv[vb]; const u32x2 sv = rsg[vb];
            u32x2 o; o.x = cvt_pk_bf16(acc[vb][0] * rstd * g4v[0] * bf_lo(sv.x), acc[vb][1] * rstd * g4v[1] * bf_hi(sv.x)); o.y = cvt_pk_bf16(acc[vb][2] * rstd * g4v[2] * bf_lo(sv.y), acc[vb][3] * rstd * g4v[3] * bf_hi(sv.y));
            *(u32x2*)(yab + (size_t)(t0 + t) * 2048 + 1024 + h * 128 + v) = o; }
    }
    __syncthreads();
}
__device__ __forceinline__ void build_router_weights(Frame& F) {
    const Args& a = *F.a; bf16_t* wrt = (bf16_t*)(F.ws + WS_WRT);
    for (int i = F.bid * NTHR + F.tid; i < 80 * 256; i += F.G * NTHR) {
        const int n = i >> 8, k0 = (i & 255) * 8; float v[8];
#pragma unroll
        for (int j = 0; j < 8; ++j) v[j] = n < 8 ? a.in[13][(size_t)(k0 + j) * 8 + n] : n < 72 ? a.in[15][(size_t)(k0 + j) * 64 + (n - 8)] : 0.f;
        u32x4 hi, lo;
#pragma unroll
        for (int q = 0; q < 4; ++q) { const unsigned h = cvt_pk_bf16(v[2 * q], v[2 * q + 1]); hi[q] = h; lo[q] = cvt_pk_bf16(v[2 * q] - bf_lo(h), v[2 * q + 1] - bf_hi(h)); }
        *(u32x4*)(wrt + (size_t)n * D + k0) = hi; *(u32x4*)(wrt + (size_t)(80 + n) * D + k0) = lo;
    }
}
__device__ __forceinline__ void route_phase(Frame& F) {
    const Args& a = *F.a; unsigned char* ws = F.ws;
    const bf16_t* x1 = (const bf16_t*)(ws + WS_YAB);   const float* g = a.in[12]; const float* brg = a.in[14]; const float* bre = a.in[16];
    const bf16_t* wrt = (const bf16_t*)(ws + WS_WRT);
    bf16_t* h2 = (bf16_t*)(ws + WS_H); int* counts = (int*)(ws + WS_CTL) + CW_COUNTS;
    LAS f32x4* slab = (LAS f32x4*)F.lds;
    LAS float* ltile = (LAS float*)(F.lds + 4 * 21 * 1024);
    const int lane = F.lane, w = F.wave, g4 = lane >> 4, l15 = lane & 15;
    for (int blk = F.bid; blk < T / 64; blk += F.G) {
        f32x4 acc[4][5]; f32x4 ssq = (f32x4){0.f, 0.f, 0.f, 0.f};
#pragma unroll
        for (int tt = 0; tt < 4; ++tt)
#pragma unroll
            for (int nb = 0; nb < 5; ++nb) acc[tt][nb] = (f32x4){0.f, 0.f, 0.f, 0.f};
        const bf16_t* xr = x1 + (size_t)(blk * 64 + l15) * D + w * 256 + 8 * g4; const float* gr = g + w * 256 + 8 * g4;
        unsigned char* hr = (unsigned char*)h2 + (size_t)(blk * 64 + l15) * D + w * 256 + 8 * g4; const bf16_t* wr = wrt + (size_t)l15 * D + w * 256 + 8 * g4;
        u32x4 xnx[4]; f32x4 gn0, gn1;
#pragma unroll
        for (int tt = 0; tt < 4; ++tt) xnx[tt] = *(const u32x4*)(xr + (size_t)(16 * tt) * D);
        gn0 = *(const f32x4*)gr; gn1 = *(const f32x4*)(gr + 4);
#pragma unroll 2
        for (int ks = 0; ks < 8; ++ks) {
            const f32x4 g0 = gn0, g1 = gn1;
            bf16x8 wh[5], wl[5];
#pragma unroll
            for (int nb = 0; nb < 5; ++nb) { wh[nb] = *(const bf16x8*)(wr + (size_t)(16 * nb) * D + 32 * ks); wl[nb] = *(const bf16x8*)(wr + (size_t)(80 + 16 * nb) * D + 32 * ks); }
            u32x4 xpv[4];
#pragma unroll
            for (int tt = 0; tt < 4; ++tt) xpv[tt] = xnx[tt];
            { const int kn = ks + 1 < 8 ? ks + 1 : 7;
#pragma unroll
              for (int tt = 0; tt < 4; ++tt) xnx[tt] = *(const u32x4*)(xr + (size_t)(16 * tt) * D + 32 * kn);
              gn0 = *(const f32x4*)(gr + 32 * kn); gn1 = *(const f32x4*)(gr + 32 * kn + 4); }
#pragma unroll
            for (int tt = 0; tt < 4; ++tt) {
                const u32x4 xp = xpv[tt]; const f32x4 x0 = (f32x4){bf_lo(xp.x), bf_hi(xp.x), bf_lo(xp.y), bf_hi(xp.y)}, x1v = (f32x4){bf_lo(xp.z), bf_hi(xp.z), bf_lo(xp.w), bf_hi(xp.w)};
                ssq[tt] += (x0[0] * x0[0] + x0[1] * x0[1]) + (x0[2] * x0[2] + x0[3] * x0[3]) + (x1v[0] * x1v[0] + x1v[1] * x1v[1]) + (x1v[2] * x1v[2] + x1v[3] * x1v[3]);
                const f32x4 y0 = x0 * g0, y1 = x1v * g1;
                u32x4 hi, lo;
                hi.x = cvt_pk_bf16_m(y0[0], y0[1]); hi.y = cvt_pk_bf16_m(y0[2], y0[3]); hi.z = cvt_pk_bf16_m(y1[0], y1[1]); hi.w = cvt_pk_bf16_m(y1[2], y1[3]);
                lo.x = cvt_pk_bf16_m(y0[0] - bf_lo(hi.x), y0[1] - bf_hi(hi.x)); lo.y = cvt_pk_bf16_m(y0[2] - bf_lo(hi.y), y0[3] - bf_hi(hi.y));
                lo.z = cvt_pk_bf16_m(y1[0] - bf_lo(hi.z), y1[1] - bf_hi(hi.z)); lo.w = cvt_pk_bf16_m(y1[2] - bf_lo(hi.w), y1[3] - bf_hi(hi.w));
                { u32x2 q8; q8.x = pk4_fp8(clamp448(y0[0]), clamp448(y0[1]), clamp448(y0[2]), clamp448(y0[3])); q8.y = pk4_fp8(clamp448(y1[0]), clamp448(y1[1]), clamp448(y1[2]), clamp448(y1[3])); *(u32x2*)(hr + (size_t)(16 * tt) * D + 32 * ks) = q8; }
                const bf16x8 bh = __builtin_bit_cast(bf16x8, hi), bl = __builtin_bit_cast(bf16x8, lo);
#pragma unroll
                for (int nb = 0; nb < 5; ++nb) { acc[tt][nb] = mfma16(wh[nb], bh, acc[tt][nb]); acc[tt][nb] = mfma16(wh[nb], bl, acc[tt][nb]); acc[tt][nb] = mfma16(wl[nb], bh, acc[tt][nb]); }
            }
        }
#pragma unroll
        for (int half = 4; half >= 1; half >>= 1) {
            __syncthreads();
            if (w >= half && w < 2 * half) { LAS f32x4* p = slab + (size_t)(w - half) * 21 * 64 + lane;
#pragma unroll
                for (int tt = 0; tt < 4; ++tt)
#pragma unroll
                    for (int nb = 0; nb < 5; ++nb) p[(tt * 5 + nb) * 64] = acc[tt][nb];
                p[20 * 64] = ssq; }
            __syncthreads();
            if (w < half) { const LAS f32x4* p = slab + (size_t)w * 21 * 64 + lane;
#pragma unroll
                for (int tt = 0; tt < 4; ++tt)
#pragma unroll
                    for (int nb = 0; nb < 5; ++nb) acc[tt][nb] += p[(tt * 5 + nb) * 64];
                ssq += p[20 * 64]; }
        }
        if (w == 0) {
#pragma unroll
            for (int tt = 0; tt < 4; ++tt) { float s = ssq[tt]; s += __shfl_xor(s, 16); s += __shfl_xor(s, 32);
                const float rs = rsqrtf(s * (1.f / D) + EPS);
                LAS float* lt = ltile + (tt * 16 + l15) * 84;
#pragma unroll
                for (int nb = 0; nb < 5; ++nb) *(LAS f32x4*)(lt + 16 * nb + 4 * g4) = acc[tt][nb] * rs;
                if (g4 == 0) lt[80] = rs; }
        }
        __syncthreads();
        LAS int* lcnt = (LAS int*)(ltile + 64 * 84); LAS int* lbase = lcnt + 64;
        if (w == 7) lcnt[lane] = 0;
        const bool tokthr = w < 4 && lane < 16;
        const int t = blk * 64 + w * 16 + lane;
        int ea = 0, eb = 0; float wa = 0.f, wb2 = 0.f, rsv = 0.f;
        if (tokthr) {
            const LAS float* lt = ltile + (w * 16 + lane) * 84;
            int gsel = 0; float gmax = lt[0] + brg[0]; float den = 0.f;
            for (int n = 1; n < 8; ++n) { const float v = lt[n] + brg[n]; if (v > gmax) { gmax = v; gsel = n; } }
            for (int n = 0; n < 8; ++n) den += expf(lt[n] + brg[n] - gmax);
            const float pg = 1.f / den;
            int i1 = 0; float v1 = lt[8 + gsel * 8] + bre[gsel * 8];
            for (int n = 1; n < 8; ++n) { const float v = lt[8 + gsel * 8 + n] + bre[gsel * 8 + n]; if (v > v1) { v1 = v; i1 = n; } }
            int i2 = 0; float v2 = -3.0e38f;
            for (int n = 0; n < 8; ++n) { const float v = lt[8 + gsel * 8 + n] + bre[gsel * 8 + n]; if (n != i1 && v > v2) { v2 = v; i2 = n; } }
            const float e2 = expf(v2 - v1); const float w1 = 1.f / (1.f + e2), w2 = e2 / (1.f + e2);
            ea = gsel * 8 + i1; eb = gsel * 8 + i2; wa = w1 * pg; wb2 = w2 * pg; rsv = lt[80];
        }
        __syncthreads();
        int ra = 0, rb = 0;
        if (tokthr) { ra = __hip_atomic_fetch_add(lcnt + ea, 1, __ATOMIC_RELAXED, __HIP_MEMORY_SCOPE_WORKGROUP); rb = __hip_atomic_fetch_add(lcnt + eb, 1, __ATOMIC_RELAXED, __HIP_MEMORY_SCOPE_WORKGROUP); }
        __syncthreads();
        if (w == 0) { const int c = lcnt[lane]; lbase[lane] = c ? atomicAdd(&counts[lane], c) : 0; }
        __syncthreads();
        if (tokthr) {
            const int pa = lbase[ea] + ra, pb = lbase[eb] + rb;
            int* ltok = (int*)(ws + WS_LTOK); float* lw = (float*)(ws + WS_LW); float* lrs = (float*)(ws + WS_LRS); int* slot_of = (int*)(ws + WS_SLOTOF);
            ltok[ea * T + pa] = t; lw[ea * T + pa] = wa; lrs[ea * T + pa] = rsv;
            ltok[eb * T + pb] = t; lw[eb * T + pb] = wb2; lrs[eb * T + pb] = rsv;
            slot_of[t * 2] = (ea << 16) | pa; slot_of[t * 2 + 1] = (eb << 16) | pb;
        }
    }
    __syncthreads();
}
__device__ __forceinline__ void moe_tile_table(Frame& F, LAS int* tstart) {
    const int* counts = (const int*)(F.ws + WS_CTL) + CW_COUNTS;
    __syncthreads();
    if (F.tid == 0) { int acc = 0; for (int e = 0; e < NE; ++e) { tstart[e] = acc; acc += (counts[e] + 255) >> 8; } tstart[NE] = acc; }
    __syncthreads();
}
__device__ __forceinline__ void assign_phase(Frame& F) {
    unsigned char* ws = F.ws;
    LAS int* tstart = (LAS int*)F.lds;
    moe_tile_table(F, tstart);
    const int* tok_e = (const int*)(ws + WS_TOKE); const float* tok_w = (const float*)(ws + WS_TOKW); int* cursor = (int*)(ws + WS_CTL) + CW_CURSOR;
    int* slot_of = (int*)(ws + WS_SLOTOF); float* slot_w = (float*)(ws + WS_SLOTW); float* slot_rs = (float*)(ws + WS_SLOTRS); const float* rstd2 = (const float*)(ws + WS_RSTD2);
    const bf16_t* h2 = (const bf16_t*)(ws + WS_H); bf16_t* xg = (bf16_t*)(ws + WS_XG);
    const int lane = F.lane, gw = F.bid * NWAVES + F.wave, NGW = F.G * NWAVES;
    for (int i = gw; i < 2 * T; i += NGW) {
        const int e = tok_e[i];
        int slot = 0;
        if (lane == 0) { slot = tstart[e] * 256 + atomicAdd(&cursor[e], 1); slot_of[i] = slot; slot_w[slot] = tok_w[i]; slot_rs[slot] = rstd2[i >> 1]; }
        slot = __shfl(slot, 0);
        const u32x4* src = (const u32x4*)(h2 + (size_t)(i >> 1) * D); u32x4* dst = (u32x4*)(xg + (size_t)slot * D);
#pragma unroll
        for (int j = 0; j < 4; ++j) dst[lane + 64 * j] = src[lane + 64 * j];
    }
}
struct MoeOrder {
    const char* A; const char* Bt; size_t a_tile, b_tile, b_expert; const LAS int* tstart; int per, xcd, rank, total;
    __device__ void init(const void* A_, const void* Bt_, int lda, int ldb, const LAS int* ts, int G, int c) {
        A = (const char*)A_; Bt = (const char*)Bt_; a_tile = (size_t)256 * lda * 2; b_tile = (size_t)256 * ldb * 2; b_expert = (size_t)2048 * ldb * 2; tstart = ts;
        per = G >> 3; xcd = c & 7; rank = c >> 3; total = ts[NE] * 8; }
    __device__ bool next(int i, pg8::Unit& u) const {
        const int L = (i * 8 + xcd) * per + rank; if (L >= total || rank >= per) return false;
        int e = 0; while (tstart[e + 1] * 8 <= L) ++e;
        const int t0 = tstart[e], nt = tstart[e + 1] - t0, r = L - t0 * 8, pn = r / nt, mt = r - pn * nt;
        u.pm = t0 + mt; u.pn = pn; u.aux = e; u.A = A + (size_t)u.pm * a_tile; u.B = Bt + (size_t)e * b_expert + (size_t)pn * b_tile; return true;
    }
};
struct EpiSwiglu {
    static constexpr bool PERM = true, HAS_MID = false;
    bf16_t* act; const float* slot_rs;
    __device__ __forceinline__ void mid(f32x4 (&)[2][2][4][2], const pg8::Unit&, int, int, int, int) const {}
    __device__ __forceinline__ void operator()(const f32x4 (&acc)[2][2][4][2], const pg8::Unit& u, int wr, int wc, int fr, int fq) const {
        const int row0 = u.pm * 256 + wr * 64 + fr, c0 = u.pn * 128 + wc * 32 + 8 * fq;
#pragma unroll
        for (int ai = 0; ai < 2; ++ai)
#pragma unroll
            for (int m = 0; m < 4; ++m) { const float rs = slot_rs[row0 + ai * 128 + m * 16]; const f32x4 g0 = acc[ai][0][m][0] * rs, g1 = acc[ai][0][m][1] * rs, u0 = acc[ai][1][m][0] * rs, u1 = acc[ai][1][m][1] * rs; float o[8];
#pragma unroll
                for (int j = 0; j < 4; ++j) { o[j] = g0[j] * fast_sigmoid(g0[j]) * u0[j]; o[4 + j] = g1[j] * fast_sigmoid(g1[j]) * u1[j]; }
                u32x4 w; w.x = cvt_pk_bf16(o[0], o[1]); w.y = cvt_pk_bf16(o[2], o[3]); w.z = cvt_pk_bf16(o[4], o[5]); w.w = cvt_pk_bf16(o[6], o[7]);
                *(u32x4*)(act + (size_t)(row0 + ai * 128 + m * 16) * DE + c0) = w; }
    }
};
struct EpiDown {
    static constexpr bool PERM = true, HAS_MID = false;
    bf16_t* yb; const float* slot_w;
    __device__ __forceinline__ void mid(f32x4 (&)[2][2][4][2], const pg8::Unit&, int, int, int, int) const {}
    __device__ __forceinline__ void operator()(const f32x4 (&acc)[2][2][4][2], const pg8::Unit& u, int wr, int wc, int fr, int fq) const {
        const int row0 = u.pm * 256 + wr * 64 + fr, c0 = u.pn * 256 + wc * 32 + 8 * fq;
#pragma unroll
        for (int ai = 0; ai < 2; ++ai)
#pragma unroll
            for (int m = 0; m < 4; ++m) { const int row = row0 + ai * 128 + m * 16; const float sw = slot_w[row];
#pragma unroll
                for (int bj = 0; bj < 2; ++bj) { const f32x4 v0 = acc[ai][bj][m][0] * sw, v1 = acc[ai][bj][m][1] * sw;
                    u32x4 w; w.x = cvt_pk_bf16(v0[0], v0[1]); w.y = cvt_pk_bf16(v0[2], v0[3]); w.z = cvt_pk_bf16(v1[0], v1[1]); w.w = cvt_pk_bf16(v1[2], v1[3]);
                    *(u32x4*)(yb + (size_t)row * D + c0 + bj * 128) = w; } }
    }
};
__device__ __forceinline__ void moe_tile_table128(Frame& F, LAS int* tstart);
#define F8(w, i) __builtin_amdgcn_cvt_f32_fp8((w), (i))
__device__ __forceinline__ void final_phase(Frame& F) {
    const Args& a = *F.a; unsigned char* ws = F.ws;
    const int* slot_of = (const int*)(ws + WS_SLOTOF); const unsigned char* yb = ws + WS_YB;   const float* g = a.in[20]; float* out = a.out; const bf16_t* x1b = (const bf16_t*)(ws + WS_YAB);
    const int lane = F.lane, gw = F.bid * NWAVES + F.wave, NGW = F.G * NWAVES;
    int n0 = 0, n1 = 0, n2 = 0, n3 = 0;
    if (gw < T) { const int rb = gw + NGW < T ? gw + NGW : gw; n0 = slot_of[gw * 2]; n1 = slot_of[gw * 2 + 1]; n2 = slot_of[rb * 2]; n3 = slot_of[rb * 2 + 1]; }
    LAS int* tstart = (LAS int*)F.lds; moe_tile_table128(F, tstart);
    f32x4 gfin[8];
#pragma unroll
    for (int j = 0; j < 8; ++j) gfin[j] = ((const f32x4*)g)[lane + 64 * j];
    u32x2 RXa[8], RXb[8]; unsigned RY0[8], RY1[8], RY2[8], RY3[8];
#define FIN_FETCH(row_, rowb_, k0_, k1_, k2_, k3_) do { \
        const int _s0 = tstart[(k0_) >> 16] * 128 + ((k0_) & 0xffff), _s1 = tstart[(k1_) >> 16] * 128 + ((k1_) & 0xffff), _s2 = tstart[(k2_) >> 16] * 128 + ((k2_) & 0xffff), _s3 = tstart[(k3_) >> 16] * 128 + ((k3_) & 0xffff); \
        const u32x2* _xa = (const u32x2*)(x1b + (size_t)(row_) * D); const u32x2* _xb = (const u32x2*)(x1b + (size_t)(rowb_) * D); \
        const unsigned* _y0 = (const unsigned*)(yb + (size_t)_s0 * D); const unsigned* _y1 = (const unsigned*)(yb + (size_t)_s1 * D); \
        const unsigned* _y2 = (const unsigned*)(yb + (size_t)_s2 * D); const unsigned* _y3 = (const unsigned*)(yb + (size_t)_s3 * D); \
        _Pragma("unroll") for (int j = 0; j < 8; ++j) { RXa[j] = _xa[lane + 64 * j]; RXb[j] = _xb[lane + 64 * j]; RY0[j] = _y0[lane + 64 * j]; RY1[j] = _y1[lane + 64 * j]; RY2[j] = _y2[lane + 64 * j]; RY3[j] = _y3[lane + 64 * j]; } } while (0)
    if (gw < T) { const int rb = gw + NGW < T ? gw + NGW : gw; FIN_FETCH(gw, rb, n0, n1, n2, n3);
        const int rn = gw + 2 * NGW; if (rn < T) { const int rnb = rn + NGW < T ? rn + NGW : rn; n0 = slot_of[rn * 2]; n1 = slot_of[rn * 2 + 1]; n2 = slot_of[rnb * 2]; n3 = slot_of[rnb * 2 + 1]; } }
    for (int row = gw; row < T; row += 2 * NGW) {
        const int rowb = row + NGW < T ? row + NGW : row;
        f32x4* xa = (f32x4*)(out + (size_t)row * D); f32x4* xb = (f32x4*)(out + (size_t)rowb * D);
        f32x4 va[8], vb[8]; float sa = 0.f, sb = 0.f;
#pragma unroll
        for (int j = 0; j < 8; ++j) { const u32x2 xq = RXa[j]; const f32x4 x = (f32x4){bf_lo(xq.x), bf_hi(xq.x), bf_lo(xq.y), bf_hi(xq.y)}; const int p = (int)RY0[j], q = (int)RY1[j];
            va[j] = (f32x4){x[0] + (F8(p, 0) + F8(q, 0)) * 0.0625f, x[1] + (F8(p, 1) + F8(q, 1)) * 0.0625f, x[2] + (F8(p, 2) + F8(q, 2)) * 0.0625f, x[3] + (F8(p, 3) + F8(q, 3)) * 0.0625f};
            sa += (va[j][0] * va[j][0] + va[j][1] * va[j][1]) + (va[j][2] * va[j][2] + va[j][3] * va[j][3]); }
#pragma unroll
        for (int j = 0; j < 8; ++j) { const u32x2 xq = RXb[j]; const f32x4 x = (f32x4){bf_lo(xq.x), bf_hi(xq.x), bf_lo(xq.y), bf_hi(xq.y)}; const int p = (int)RY2[j], q = (int)RY3[j];
            vb[j] = (f32x4){x[0] + (F8(p, 0) + F8(q, 0)) * 0.0625f, x[1] + (F8(p, 1) + F8(q, 1)) * 0.0625f, x[2] + (F8(p, 2) + F8(q, 2)) * 0.0625f, x[3] + (F8(p, 3) + F8(q, 3)) * 0.0625f};
            sb += (vb[j][0] * vb[j][0] + vb[j][1] * vb[j][1]) + (vb[j][2] * vb[j][2] + vb[j][3] * vb[j][3]); }
        { const int rn = row + 2 * NGW;
          if (rn < T) { const int rnb = rn + NGW < T ? rn + NGW : rn; FIN_FETCH(rn, rnb, n0, n1, n2, n3);
              const int r2 = rn + 2 * NGW; if (r2 < T) { const int r2b = r2 + NGW < T ? r2 + NGW : r2; n0 = slot_of[r2 * 2]; n1 = slot_of[r2 * 2 + 1]; n2 = slot_of[r2b * 2]; n3 = slot_of[r2b * 2 + 1]; } } }
        const float ra = rsqrtf(wave_sum(sa) * (1.f / D) + EPS), rb = rsqrtf(wave_sum(sb) * (1.f / D) + EPS);
#pragma unroll
        for (int j = 0; j < 8; ++j) { const f32x4 gg = gfin[j]; xa[lane + 64 * j] = va[j] * ra * gg; if (rowb != row) xb[lane + 64 * j] = vb[j] * rb * gg; }
    }
#undef FIN_FETCH
}
namespace mg {
constexpr int BPITCH = 144, A_BYTES = 16384, STG = A_BYTES + 256 * BPITCH  ;
__device__ __forceinline__ int inv_perm32(int c) { return ((c >> 2) & 1) * 16 + ((c >> 3) << 2) + (c & 3); }
struct Unit { const float* B0; const float* B1; int pm, pn, e; };
struct Order {
    const LAS int* tstart; int per, xcd, rank, total; const float* W0; const float* W1; size_t wexp; int up;
    __device__ void init(const LAS int* ts, int G, int c, const float* W0_, const float* W1_, size_t wexp_, int up_) { tstart = ts; per = G >> 3; xcd = c & 7; rank = c >> 3; total = ts[NE] * 8; W0 = W0_; W1 = W1_; wexp = wexp_; up = up_; }
    __device__ bool next(int i, Unit& u) const {
        const int L = (i * 8 + xcd) * per + rank; if (L >= total || rank >= per) return false;
        int e = 0; while (tstart[e + 1] * 8 <= L) ++e;
        const int t0 = tstart[e], nt = tstart[e + 1] - t0, r = L - t0 * 8, pn = r / nt, mt = r - pn * nt;
        u.pm = t0 + mt; u.pn = pn; u.e = e;
        if (up) { u.B0 = W0 + (size_t)e * wexp + pn * 128; u.B1 = W1 + (size_t)e * wexp + pn * 128; }
        else { u.B0 = W0 + (size_t)e * wexp + pn * 256; u.B1 = u.B0 + 128; }
        return true;
    }
};
template <class Epi, bool GATHER>
__device__ __forceinline__ void gemm(LAS unsigned char* lds, const bf16_t* Abase, int lda, const int* row_idx, int K, int ldb, const Order& S, const Epi& E) {
    const int tid = threadIdx.x, wid = __builtin_amdgcn_readfirstlane(tid >> 6), lane = tid & 63, wr = wid >> 2, wc = wid & 3, fr = lane & 15, fq = lane >> 4;
    const int nt = K / 64;
    int Rr[2], Cc[2];
#pragma unroll
    for (int i = 0; i < 2; ++i) pg8::stage_rc(tid * 16 + i * 8192, Rr[i], Cc[i]);
    const unsigned ldsw = (unsigned)wid * 1024u;
    const int aoff = pg8::lds_byte(wr * 64 + fr, fq * 8), boff = A_BYTES + (wc * 32 + fr) * BPITCH + fq * 16;
    unsigned wrow[2][2];
#pragma unroll
    for (int h = 0; h < 2; ++h)
#pragma unroll
        for (int j = 0; j < 2; ++j) { const int n = 2 * lane + j; wrow[h][j] = (unsigned)(A_BYTES + (h * 128 + (n & ~31) + inv_perm32(n & 31)) * BPITCH + 16 * wid); }
#define MG_DMA_A(stage, t) do { _Pragma("unroll") for (int _i = 0; _i < 2; ++_i) \
        __builtin_amdgcn_global_load_lds((const unsigned*)((const char*)Abase + voffA[_i] + (size_t)(t) * 128), (LAS unsigned*)(lds + (stage) * STG + ldsw + _i * 8192), 16, 0, 0); } while (0)
#define MG_LOADB(set, t) do { const unsigned _vo = (unsigned)(2 * lane) * 4u; const size_t _kr = (size_t)(64 * (t) + 8 * wid) * ldb; _Pragma("unroll") for (int _i = 0; _i < 8; ++_i) { \
        asm volatile("global_load_dwordx2 %0, %1, %2" : "=v"(set[0][_i]) : "v"(_vo), "s"(u.B0 + _kr + (size_t)_i * ldb) : "memory"); asm volatile("global_load_dwordx2 %0, %1, %2" : "=v"(set[1][_i]) : "v"(_vo), "s"(u.B1 + _kr + (size_t)_i * ldb) : "memory"); } } while (0)
#define MG_CVTW(set, stage) do { _Pragma("unroll") for (int _h = 0; _h < 2; ++_h) _Pragma("unroll") for (int _j = 0; _j < 2; ++_j) { u32x4 _w; \
        _w.x = cvt_pk_bf16(set[_h][0][_j], set[_h][1][_j]); _w.y = cvt_pk_bf16(set[_h][2][_j], set[_h][3][_j]); _w.z = cvt_pk_bf16(set[_h][4][_j], set[_h][5][_j]); _w.w = cvt_pk_bf16(set[_h][6][_j], set[_h][7][_j]); \
        *(LAS u32x4*)(lds + (stage) * STG + wrow[_h][_j]) = _w; } } while (0)
#define MG_LDFRAG(stage) do { _Pragma("unroll") for (int n = 0; n < 2; ++n) _Pragma("unroll") for (int k = 0; k < 2; ++k) { \
        B0[n][k] = *(const LAS bf16x8*)(lds + (stage) * STG + boff + (n * 16) * BPITCH + k * 64); B1[n][k] = *(const LAS bf16x8*)(lds + (stage) * STG + boff + (128 + n * 16) * BPITCH + k * 64); } \
        _Pragma("unroll") for (int m = 0; m < 4; ++m) _Pragma("unroll") for (int k = 0; k < 2; ++k) At[m][k] = *(const LAS bf16x8*)(lds + (stage) * STG + aoff + m * 2048 + k * 1024); } while (0)
#define MG_MMA() do { __builtin_amdgcn_s_setprio(1); _Pragma("unroll") for (int m = 0; m < 4; ++m) _Pragma("unroll") for (int n = 0; n < 2; ++n) _Pragma("unroll") for (int k = 0; k < 2; ++k) { \
        acc[0][m][n] = __builtin_amdgcn_mfma_f32_16x16x32_bf16(B0[n][k], At[m][k], acc[0][m][n], 0, 0, 0); acc[1][m][n] = __builtin_amdgcn_mfma_f32_16x16x32_bf16(B1[n][k], At[m][k], acc[1][m][n], 0, 0, 0); } __builtin_amdgcn_s_setprio(0); } while (0)
#define MG_W1() do { asm volatile("s_waitcnt vmcnt(16)" ::: "memory"); asm volatile("s_waitcnt lgkmcnt(0)" ::: "memory"); __builtin_amdgcn_s_barrier(); asm volatile("" ::: "memory"); } while (0)
    Unit u;
    for (int ui = 0; S.next(ui, u); ++ui) {
        unsigned voffA[2];
#pragma unroll
        for (int i = 0; i < 2; ++i) { const int slot = u.pm * 128 + Rr[i]; const int idx = GATHER ? row_idx[slot] : slot; voffA[i] = (unsigned)(idx * lda + Cc[i]) * 2u; }
        f32x4 acc[2][4][2];
#pragma unroll
        for (int b = 0; b < 2; ++b)
#pragma unroll
            for (int m = 0; m < 4; ++m)
#pragma unroll
                for (int n = 0; n < 2; ++n) acc[b][m][n] = (f32x4){0.f, 0.f, 0.f, 0.f};
        bf16x8 At[4][2], B0[2][2], B1[2][2];
        f32x2 sa[2][8], sb[2][8];
        MG_DMA_A(0, 0);
        MG_LOADB(sa, 0); MG_LOADB(sb, 1);
        asm volatile("s_waitcnt vmcnt(16)" ::: "memory");
        MG_CVTW(sa, 0);
        MG_LOADB(sa, 2);
        for (int t = 0; t < nt; t += 2) {
            const int t1 = t + 1 < nt ? t + 1 : nt - 1, t2 = t + 2 < nt ? t + 2 : nt - 1, t3 = t + 3 < nt ? t + 3 : nt - 1, t4 = t + 4 < nt ? t + 4 : nt - 1;
            MG_W1();
            MG_LDFRAG(0);
            MG_CVTW(sb, 1);
            MG_DMA_A(1, t1); MG_LOADB(sb, t3);
            asm volatile("s_waitcnt lgkmcnt(0)" ::: "memory");
            MG_MMA();
            MG_W1();
            MG_LDFRAG(1);
            MG_CVTW(sa, 0);
            MG_DMA_A(0, t2); MG_LOADB(sa, t4);
            asm volatile("s_waitcnt lgkmcnt(0)" ::: "memory");
            MG_MMA();
        }
        asm volatile("s_waitcnt vmcnt(0)" ::: "memory"); asm volatile("s_waitcnt lgkmcnt(0)" ::: "memory"); __builtin_amdgcn_s_barrier(); asm volatile("" ::: "memory");
        E(acc, u, wr, wc, fr, fq);
    }
#undef MG_DMA_A
#undef MG_LOADB
#undef MG_CVTW
#undef MG_LDFRAG
#undef MG_MMA
#undef MG_W1
}
}

__device__ __forceinline__ void moe_tile_table128(Frame& F, LAS int* tstart) {
    const int* counts = (const int*)(F.ws + WS_CTL) + CW_COUNTS;
    __syncthreads();
    if (F.tid < NE) { const int n = (counts[F.tid] + 127) >> 7; int incl = n;
#pragma unroll
        for (int d = 1; d < 64; d <<= 1) { const int v = __shfl_up(incl, d); if (F.tid >= d) incl += v; }
        tstart[F.tid] = incl - n; if (F.tid == NE - 1) tstart[NE] = incl; tstart[160 + F.tid] = counts[F.tid]; }
    __syncthreads();
    if (F.tid < NE) { const int e = F.tid, ne = tstart[e + 1] - tstart[e]; int j = 0;
        for (int o = 0; o < NE; ++o) { const int no = tstart[o + 1] - tstart[o]; j += (no > ne || (no == ne && o < e)) ? 1 : 0; }
        const int pos = j < 16 ? j : j < 32 ? 16 + (31 - j) : j < 48 ? 32 + (j - 32) : 48 + (63 - j);
        tstart[80 + pos] = e; }
    __syncthreads();
}
__device__ __forceinline__ void assign_phase2(Frame& F) {
    unsigned char* ws = F.ws;
    LAS int* tstart = (LAS int*)F.lds;
    moe_tile_table128(F, tstart);
    const int* tok_e = (const int*)(ws + WS_TOKE); const float* tok_w = (const float*)(ws + WS_TOKW); int* cursor = (int*)(ws + WS_CTL) + CW_CURSOR; const int* counts = (const int*)(ws + WS_CTL) + CW_COUNTS;
    int* slot_of = (int*)(ws + WS_SLOTOF); float* slot_w = (float*)(ws + WS_SLOTW); float* slot_rs = (float*)(ws + WS_SLOTRS); const float* rstd2 = (const float*)(ws + WS_RSTD2); int* row_idx = (int*)(ws + WS_ROWIDX);
    if (F.bid == 0 && F.tid < NE) { const int e = F.tid, base = tstart[e] * 128, end = tstart[e + 1] * 128;
        for (int s = base + counts[e]; s < end; ++s) { row_idx[s] = 0; slot_w[s] = 0.f; slot_rs[s] = 1.f; } }
    for (int i = F.bid * NTHR + F.tid; i < 2 * T; i += F.G * NTHR) {
        const int e = tok_e[i]; const int slot = tstart[e] * 128 + atomicAdd(&cursor[e], 1);
        slot_of[i] = slot; row_idx[slot] = i >> 1; slot_w[slot] = tok_w[i]; slot_rs[slot] = rstd2[i >> 1];
    }
}
struct EpiSwiglu128 {
    bf16_t* act; const float* slot_rs;
    __device__ __forceinline__ void operator()(const f32x4 (&acc)[2][4][2], const mg::Unit& u, int wr, int wc, int fr, int fq) const {
        const int row0 = u.pm * 128 + wr * 64 + fr, c0 = u.pn * 128 + wc * 32 + 8 * fq;
#pragma unroll
        for (int m = 0; m < 4; ++m) { const int row = row0 + m * 16; const float rs = slot_rs[row]; const f32x4 g0 = acc[0][m][0] * rs, g1 = acc[0][m][1] * rs, u0 = acc[1][m][0] * rs, u1 = acc[1][m][1] * rs; float o[8];
#pragma unroll
            for (int j = 0; j < 4; ++j) { o[j] = g0[j] * fast_sigmoid(g0[j]) * u0[j]; o[4 + j] = g1[j] * fast_sigmoid(g1[j]) * u1[j]; }
            u32x4 w; w.x = cvt_pk_bf16(o[0], o[1]); w.y = cvt_pk_bf16(o[2], o[3]); w.z = cvt_pk_bf16(o[4], o[5]); w.w = cvt_pk_bf16(o[6], o[7]);
            *(u32x4*)(act + (size_t)row * DE + c0) = w; }
    }
};
struct EpiDown128 {
    bf16_t* yb; const float* slot_w;
    __device__ __forceinline__ void operator()(const f32x4 (&acc)[2][4][2], const mg::Unit& u, int wr, int wc, int fr, int fq) const {
        const int row0 = u.pm * 128 + wr * 64 + fr, c0 = u.pn * 256 + wc * 32 + 8 * fq;
#pragma unroll
        for (int m = 0; m < 4; ++m) { const int row = row0 + m * 16; const float sw = slot_w[row];
#pragma unroll
            for (int bj = 0; bj < 2; ++bj) { const f32x4 v0 = acc[bj][m][0] * sw, v1 = acc[bj][m][1] * sw;
                u32x4 w; w.x = cvt_pk_bf16(v0[0], v0[1]); w.y = cvt_pk_bf16(v0[2], v0[3]); w.z = cvt_pk_bf16(v1[0], v1[1]); w.w = cvt_pk_bf16(v1[2], v1[3]);
                *(u32x4*)(yb + (size_t)row * D + c0 + bj * 128) = w; } }
    }
};
namespace mg2 {
constexpr int MAXSUB = 5, ASTG = MAXSUB * 8192  , BP = 80, BSTG = 128 * BP  , RSLOT = 16384;
constexpr int OFF_A = 0, OFF_B = 2 * ASTG  , OFF_R = OFF_B + 2 * BSTG  , LDS_END = OFF_R + 3 * RSLOT  ;
__device__ __forceinline__ int swz(int ob) { return ob ^ (((ob >> 9) & 1) << 5); }
__device__ __forceinline__ void dma16_s(const void* sbase, unsigned voff, unsigned lds_dst) {
    unsigned keep;
    asm volatile("s_mov_b32 %0, m0\n\ts_mov_b32 m0, %3\n\ts_nop 0\n\tglobal_load_lds_dwordx4 %1, %2\n\ts_mov_b32 m0, %0" : "=&s"(keep) : "v"(voff), "s"(sbase), "s"(lds_dst) : "memory");
}
struct Unit { int slab, row0, rows_valid; };
template <bool UP, class Epi>
__device__ __forceinline__ void gemm(LAS unsigned char* lds, const bf16_t* Abase, int lda, const int* row_idx, int K, int ldb, const float* W0, const float* W1, size_t wexp,
                                     const LAS int* tstart, const int* cnts, int G, int c, const Epi& E) {
    const int tid = threadIdx.x, wid = __builtin_amdgcn_readfirstlane(tid >> 6), lane = tid & 63, wr = wid >> 1, wc = wid & 1, fr = lane & 15, fq = lane >> 4;
    const int nt = K / 32;
    const bool awave = wid < 4; const int wb = wid & 3;
    const int pA = lane * 16, obA = swz(pA), rrA = obA >> 6, ccA = (obA & 63) >> 1;
    const int aoff = swz(fr * 64 + fq * 16);
    const int boff = OFF_B + (wc * 64 + fr) * BP + fq * 16;
    const int hl = lane >> 5, c4 = lane & 31;
    unsigned wofs_c[2];
#pragma unroll
    for (int j = 0; j < 2; ++j) { const int col = 4 * c4 + 2 * hl + j; int slot;
        if (UP) { const int up = col >> 6, g = col & 63; slot = (g >> 5) * 64 + (up * 2 + ((g >> 4) & 1)) * 16 + (g & 15); } else slot = col;
        wofs_c[j] = (unsigned)(OFF_B + slot * BP + 16 * wb); }
    const int rro_c = OFF_R + (wb * 4) * 1024 + c4 * 16 + hl * 8;
    const unsigned ldsA = (unsigned)(size_t)(lds + OFF_A);
    const int per = G >> 3, xcd = c & 7, rank = c >> 3;
    for (int ui = 0;; ++ui) {
        const int L = (ui * 8 + xcd) * per + rank; if (L >= NE * 16 || rank >= per) break;
        const int e = tstart[80 + (L >> 4)], slab = L & 15, slot0 = tstart[e] * 128, nsub_total = tstart[e + 1] - tstart[e];
        const float* bsrc;
        if (UP) bsrc = (c4 < 16 ? W0 : W1) + (size_t)e * wexp + slab * 64 + 4 * (c4 & 15); else bsrc = W0 + (size_t)e * wexp + slab * 128 + 4 * c4;
        bsrc += (size_t)(8 * wb + hl) * ldb;
        for (int sub0 = 0; sub0 < nsub_total; sub0 += MAXSUB) {
            const int nsub = (nsub_total - sub0) < MAXSUB ? (nsub_total - sub0) : MAXSUB;
            const int rows_valid = (cnts[e] - sub0 * 128) < nsub * 128 ? (cnts[e] - sub0 * 128) : nsub * 128;
            unsigned voff[10];
#pragma unroll
            for (int i = 0; i < 10; ++i) { const int q = i * 4 + wb; int idx = 0;
                if (awave && q * 16 < rows_valid) { const int row = slot0 + sub0 * 128 + 16 * q + rrA; idx = row_idx ? row_idx[row] : row; }
                voff[i] = (unsigned)(idx * lda + ccA) * 2u; }
            if (!awave) { voff[0] = wofs_c[0]; voff[1] = wofs_c[1]; voff[2] = (unsigned)rro_c; voff[3] = (unsigned)(size_t)bsrc; voff[4] = (unsigned)((size_t)bsrc >> 32); }
            f32x4 acc[MAXSUB][2][4];
#pragma unroll
            for (int s = 0; s < MAXSUB; ++s)
#pragma unroll
                for (int m = 0; m < 2; ++m)
#pragma unroll
                    for (int n = 0; n < 4; ++n) acc[s][m][n] = (f32x4){0.f, 0.f, 0.f, 0.f};
#define M2_DMA_A(stage, t) do { const char* _sb = (const char*)Abase + (size_t)(t) * 64; _Pragma("unroll") for (int _i = 0; _i < 10; ++_i) if ((_i * 4 + wb) * 16 < rows_valid) \
        dma16_s(_sb, voff[_i], ldsA + (unsigned)((stage) * ASTG + (_i * 4 + wb) * 1024)); } while (0)
#define M2_DMA_B(rs, t) do { _Pragma("unroll") for (int _i = 0; _i < 4; ++_i) \
        __builtin_amdgcn_global_load_lds((const unsigned*)((const float*)(((size_t)voff[4] << 32) | voff[3]) + (size_t)(32 * (t) + 2 * _i) * ldb), (LAS unsigned*)(lds + OFF_R + (rs) * RSLOT + (wb * 4 + _i) * 1024), 16, 0, 2); } while (0)
#define M2_CVT(rs, stage) do { f32x2 _v[8]; _Pragma("unroll") for (int _i = 0; _i < 4; ++_i) _Pragma("unroll") for (int _h = 0; _h < 2; ++_h) _v[2 * _i + _h] = *(const LAS f32x2*)(lds + voff[2] + (rs) * RSLOT + _i * 1024 + _h * 512); \
        _Pragma("unroll") for (int _j = 0; _j < 2; ++_j) { u32x4 _w; _w.x = cvt_pk_bf16(_v[0][_j], _v[1][_j]); _w.y = cvt_pk_bf16(_v[2][_j], _v[3][_j]); _w.z = cvt_pk_bf16(_v[4][_j], _v[5][_j]); _w.w = cvt_pk_bf16(_v[6][_j], _v[7][_j]); \
            *(LAS u32x4*)(lds + (stage) * BSTG + voff[_j]) = _w; } } while (0)
            if (awave) { M2_DMA_A(0, 0); }
            else { M2_DMA_B(0, 0); M2_DMA_B(1, 1); M2_DMA_B(2, 2); asm volatile("s_waitcnt vmcnt(8)" ::: "memory"); M2_CVT(0, 0); }
            int r1 = 1, r3 = 0;
            for (int t = 0; t < nt; ++t) {
                const int st = t & 1, tn1 = t + 1 < nt ? t + 1 : nt - 1, tn3 = t + 3 < nt ? t + 3 : nt - 1;
                if (awave) asm volatile("s_waitcnt vmcnt(0)" ::: "memory"); else asm volatile("s_waitcnt vmcnt(4)" ::: "memory");
                asm volatile("s_waitcnt lgkmcnt(0)" ::: "memory"); __builtin_amdgcn_s_barrier(); asm volatile("" ::: "memory");
                if (awave) { M2_DMA_A(st ^ 1, tn1); }
                else { M2_CVT(r1, st ^ 1); asm volatile("s_waitcnt lgkmcnt(0)" ::: "memory"); M2_DMA_B(r3, tn3); }
                r1 = r1 == 2 ? 0 : r1 + 1; r3 = r3 == 2 ? 0 : r3 + 1;
                bf16x8 Bf[4];
#pragma unroll
                for (int n = 0; n < 4; ++n) Bf[n] = *(const LAS bf16x8*)(lds + st * BSTG + boff + n * 16 * BP);
#pragma unroll
                for (int s = 0; s < MAXSUB; ++s) if (s * 128 + wr * 32 < rows_valid) {
                    bf16x8 Af[2];
#pragma unroll
                    for (int m = 0; m < 2; ++m) Af[m] = *(const LAS bf16x8*)(lds + OFF_A + st * ASTG + (s * 8 + wr * 2 + m) * 1024 + aoff);
                    __builtin_amdgcn_s_setprio(1);
#pragma unroll
                    for (int m = 0; m < 2; ++m)
#pragma unroll
                        for (int n = 0; n < 4; ++n) acc[s][m][n] = __builtin_amdgcn_mfma_f32_16x16x32_bf16(Bf[n], Af[m], acc[s][m][n], 0, 0, 0);
                    __builtin_amdgcn_s_setprio(0);
                }
            }
            asm volatile("s_waitcnt vmcnt(0)" ::: "memory"); asm volatile("s_waitcnt lgkmcnt(0)" ::: "memory"); __builtin_amdgcn_s_barrier(); asm volatile("" ::: "memory");
            Unit u{slab, slot0 + sub0 * 128, rows_valid};
            E(acc, u, wr, wc, fr, fq);
#undef M2_DMA_A
#undef M2_DMA_B
#undef M2_CVT
        }
    }
}
}

struct EpiSwiglu3 {
    bf16_t* act; const float* slot_rs;
    __device__ __forceinline__ void operator()(const f32x4 (&acc)[mg2::MAXSUB][2][4], const mg2::Unit& u, int wr, int wc, int fr, int fq) const {
#pragma unroll
        for (int s = 0; s < mg2::MAXSUB; ++s)
#pragma unroll
            for (int m = 0; m < 2; ++m) if (s * 128 + wr * 32 + m * 16 < u.rows_valid) { const int row = u.row0 + s * 128 + wr * 32 + m * 16 + fr; const float rs = slot_rs[row];
#pragma unroll
                for (int n = 0; n < 2; ++n) { const f32x4 g = acc[s][m][n] * rs, v = acc[s][m][n + 2] * rs; float o[4];
#pragma unroll
                    for (int j = 0; j < 4; ++j) o[j] = g[j] * fast_sigmoid(g[j]) * v[j];
                    u32x2 w; w.x = cvt_pk_bf16(o[0], o[1]); w.y = cvt_pk_bf16(o[2], o[3]);
                    *(u32x2*)(act + (size_t)row * DE + u.slab * 64 + wc * 32 + n * 16 + 4 * fq) = w; } }
    }
};
struct EpiDown3 {
    bf16_t* yb; const float* slot_w;
    __device__ __forceinline__ void operator()(const f32x4 (&acc)[mg2::MAXSUB][2][4], const mg2::Unit& u, int wr, int wc, int fr, int fq) const {
#pragma unroll
        for (int s = 0; s < mg2::MAXSUB; ++s)
#pragma unroll
            for (int m = 0; m < 2; ++m) if (s * 128 + wr * 32 + m * 16 < u.rows_valid) { const int row = u.row0 + s * 128 + wr * 32 + m * 16 + fr; const float sw = slot_w[row];
#pragma unroll
                for (int n = 0; n < 4; ++n) { const f32x4 v = acc[s][m][n] * sw; u32x2 w; w.x = cvt_pk_bf16(v[0], v[1]); w.y = cvt_pk_bf16(v[2], v[3]);
                    *(u32x2*)(yb + (size_t)row * D + u.slab * 128 + wc * 64 + n * 16 + 4 * fq) = w; } }
    }
};

namespace mg3 {
constexpr int MAXSUB = 5, ASTG = MAXSUB * 128 * 32  , BP = 40, BSTG = 128 * BP  , RSLOT = 16384;
constexpr int OFF_A = 0, OFF_B = 3 * ASTG  , OFF_R = OFF_B + 2 * BSTG  , LDS_END = OFF_R + 4 * RSLOT  ;
constexpr float WSCALE = 64.f, WINV = 1.f / 64.f;
struct Unit { int slab, row0, rows_valid, lbase; };
#define M3_WAITV(np) do { if ((np) >= 5) asm volatile("s_waitcnt vmcnt(5)" ::: "memory"); else if ((np) == 4) asm volatile("s_waitcnt vmcnt(4)" ::: "memory"); else if ((np) == 3) asm volatile("s_waitcnt vmcnt(3)" ::: "memory"); \
        else if ((np) == 2) asm volatile("s_waitcnt vmcnt(2)" ::: "memory"); else if ((np) == 1) asm volatile("s_waitcnt vmcnt(1)" ::: "memory"); else asm volatile("s_waitcnt vmcnt(0)" ::: "memory"); } while (0)
__device__ __forceinline__ void dma16_v_nt(const void* vaddr, unsigned lds_dst) {
    unsigned keep;
    asm volatile("s_mov_b32 %0, m0\n\ts_mov_b32 m0, %2\n\ts_nop 0\n\tglobal_load_lds_dwordx4 %1, off nt\n\ts_mov_b32 m0, %0" : "=&s"(keep) : "v"(vaddr), "s"(lds_dst) : "memory");
}
template <bool UP, class Epi>
__device__ __forceinline__ void gemm(LAS unsigned char* lds, const unsigned char* Abase, int lda, const int* ltok, int K, int ldb, const float* W0, const float* W1, size_t wexp,
                                     const LAS int* tstart, const LAS int* cnts, int G, int c, const Epi& E) {
    const int tid = threadIdx.x, wid = __builtin_amdgcn_readfirstlane(tid >> 6), lane = tid & 63, wr = wid >> 1, wc = wid & 1, fr = lane & 15, fq = lane >> 4;
    const int nt = K / 32;
    const bool awave = wid < 4; const int wb = wid & 3;
    const int aoff = OFF_A + (wr * 32 + fr) * 32 + fq * 8;
    const int boff = OFF_B + (wc * 64 + fr) * BP + fq * 8;
    const int hl = lane >> 5, c4 = lane & 31;
    unsigned wofs_c[2];
#pragma unroll
    for (int j = 0; j < 2; ++j) { const int col = 4 * c4 + 2 * hl + j; int slot;
        if (UP) { const int up = col >> 6, g = col & 63; slot = (g >> 5) * 64 + (up * 2 + ((g >> 4) & 1)) * 16 + (g & 15); } else slot = col;
        wofs_c[j] = (unsigned)(OFF_B + slot * BP + 8 * wb); }
    const int rro_c = OFF_R + (wb * 4) * 1024 + c4 * 16 + hl * 8;
    const unsigned ldsA = (unsigned)(size_t)(lds + OFF_A), ldsR = (unsigned)(size_t)(lds + OFF_R);
    const int per = G >> 3, xcd = c & 7, rank = c >> 3;
    for (int ui = 0;; ++ui) {
        const int L = (ui * 8 + xcd) * per + rank; if (L >= NE * 16 || rank >= per) break;
        const int e = tstart[80 + (L >> 4)], slab = L & 15, slot0 = tstart[e] * 128, nsub_total = tstart[e + 1] - tstart[e];
        const float* bsrc;
        if (UP) bsrc = (c4 < 16 ? W0 : W1) + (size_t)e * wexp + slab * 64 + 4 * (c4 & 15); else bsrc = W0 + (size_t)e * wexp + slab * 128 + 4 * c4;
        bsrc += (size_t)(8 * wb + hl) * ldb;
        for (int sub0 = 0; sub0 < nsub_total; sub0 += MAXSUB) {
            const int nsub = (nsub_total - sub0) < MAXSUB ? (nsub_total - sub0) : MAXSUB;
            const int rows_valid = (cnts[e] - sub0 * 128) < nsub * 128 ? (cnts[e] - sub0 * 128) : nsub * 128;
            unsigned voff[5]; int np = 0;
#pragma unroll
            for (int i = 0; i < 5; ++i) { const int q = i * 4 + wb; int idx = 0;
                if (awave && q * 32 < rows_valid) { const int lrow = sub0 * 128 + 32 * q + (lane >> 1); idx = ltok ? (lrow < cnts[e] ? ltok[e * T + lrow] : 0) : slot0 + lrow; ++np; }
                voff[i] = (unsigned)(idx * lda + (lane & 1) * 16); }
            if (!awave) { voff[0] = wofs_c[0]; voff[1] = wofs_c[1]; voff[2] = (unsigned)rro_c; voff[3] = (unsigned)(size_t)bsrc; voff[4] = (unsigned)((size_t)bsrc >> 32); }
            f32x4 acc[MAXSUB][2][4];
#pragma unroll
            for (int s = 0; s < MAXSUB; ++s)
#pragma unroll
                for (int m = 0; m < 2; ++m)
#pragma unroll
                    for (int n = 0; n < 4; ++n) acc[s][m][n] = (f32x4){0.f, 0.f, 0.f, 0.f};
#define M3_DMA_A(stage, t) do { const char* _sb = (const char*)Abase + (size_t)(t) * 32; _Pragma("unroll") for (int _i = 0; _i < 5; ++_i) if ((_i * 4 + wb) * 32 < rows_valid) \
        mg2::dma16_s(_sb, voff[_i], ldsA + (unsigned)((stage) * ASTG + (_i * 4 + wb) * 1024)); } while (0)
#define M3_DMA_B(rs, t) do { _Pragma("unroll") for (int _i = 0; _i < 4; ++_i) \
        dma16_v_nt((const float*)(((size_t)voff[4] << 32) | voff[3]) + (size_t)(32 * (t) + 2 * _i) * ldb, ldsR + (unsigned)((rs) * RSLOT + (wb * 4 + _i) * 1024)); } while (0)
#define M3_CVT_LOAD(rs) do { _Pragma("unroll") for (int _i = 0; _i < 4; ++_i) _Pragma("unroll") for (int _h = 0; _h < 2; ++_h) rv[2 * _i + _h] = *(const LAS f32x2*)(lds + voff[2] + (rs) * RSLOT + _i * 1024 + _h * 512); } while (0)
#define M3_CVT_STORE(stage) do { _Pragma("unroll") for (int _j = 0; _j < 2; ++_j) { u32x2 _w; _w.x = pk4_fp8(rv[0][_j] * WSCALE, rv[1][_j] * WSCALE, rv[2][_j] * WSCALE, rv[3][_j] * WSCALE); \
            _w.y = pk4_fp8(rv[4][_j] * WSCALE, rv[5][_j] * WSCALE, rv[6][_j] * WSCALE, rv[7][_j] * WSCALE); *(LAS u32x2*)(lds + (stage) * BSTG + voff[_j]) = _w; } } while (0)
            f32x2 rv[8];
#pragma unroll
            for (int i = 0; i < 8; ++i) rv[i] = (f32x2){0.f, 0.f};
            if (awave) { M3_DMA_A(0, 0); M3_DMA_A(1, 1); }
            else { M3_DMA_B(0, 0); M3_DMA_B(1, 1); M3_DMA_B(2, 2); M3_DMA_B(3, 3); asm volatile("s_waitcnt vmcnt(12)" ::: "memory"); M3_CVT_LOAD(0); M3_CVT_STORE(0);
                   asm volatile("s_waitcnt vmcnt(8)" ::: "memory"); M3_CVT_LOAD(1); }
            int sA = 0, sA2 = 2;
            for (int t = 0; t < nt; ++t) {
                const int st = t & 1, tn2 = t + 2 < nt ? t + 2 : nt - 1, tn4 = t + 4 < nt ? t + 4 : nt - 1;
                if (awave) { M3_WAITV(np); }
                asm volatile("s_waitcnt lgkmcnt(0)" ::: "memory"); __builtin_amdgcn_s_barrier(); asm volatile("" ::: "memory");
                if (awave) { M3_DMA_A(sA2, tn2); }
                else { M3_CVT_STORE(st ^ 1); M3_DMA_B(t & 3, tn4); }
                long Bf[4];
#pragma unroll
                for (int n = 0; n < 4; ++n) Bf[n] = *(const LAS long*)(lds + st * BSTG + boff + n * 16 * BP);
#pragma unroll
                for (int s = 0; s < MAXSUB; ++s) if (s * 128 + wr * 32 < rows_valid) {
                    long Af[2];
#pragma unroll
                    for (int m = 0; m < 2; ++m) Af[m] = *(const LAS long*)(lds + sA * ASTG + aoff + (s * 128 + m * 16) * 32);
                    __builtin_amdgcn_s_setprio(1);
#pragma unroll
                    for (int m = 0; m < 2; ++m)
#pragma unroll
                        for (int n = 0; n < 4; ++n) acc[s][m][n] = __builtin_amdgcn_mfma_f32_16x16x32_fp8_fp8(Bf[n], Af[m], acc[s][m][n], 0, 0, 0);
                    __builtin_amdgcn_s_setprio(0);
                }
                sA = sA == 2 ? 0 : sA + 1; sA2 = sA2 == 2 ? 0 : sA2 + 1;
                if (!awave) { asm volatile("s_waitcnt vmcnt(8)" ::: "memory"); M3_CVT_LOAD((t + 2) & 3); }
            }
            asm volatile("s_waitcnt vmcnt(0)" ::: "memory"); asm volatile("s_waitcnt lgkmcnt(0)" ::: "memory"); __builtin_amdgcn_s_barrier(); asm volatile("" ::: "memory");
            Unit u{slab, slot0 + sub0 * 128, rows_valid, e * T + sub0 * 128};
            E(acc, u, wr, wc, fr, fq);
#undef M3_DMA_A
#undef M3_DMA_B
#undef M3_CVT_LOAD
#undef M3_CVT_STORE
        }
    }
}

constexpr int DSTG = MAXSUB * 128 * 64  , OFF_B2 = 2 * DSTG  , OFF_R2 = OFF_B2 + 2 * BSTG  , LDS_END2 = OFF_R2 + 3 * RSLOT  ;
template <bool UP, class Epi>
__device__ __forceinline__ void gemm64(LAS unsigned char* lds, const unsigned char* Abase, int lda, const int* ltok, int K, int ldb, const float* W0, const float* W1, size_t wexp,
                                       const LAS int* tstart, const LAS int* cnts, int G, int c, const Epi& E) {
    const int tid = threadIdx.x, wid = __builtin_amdgcn_readfirstlane(tid >> 6), lane = tid & 63, wr = wid >> 1, wc = wid & 1, fr = lane & 15, fq = lane >> 4;
    const int nt = K / 32;
    const bool awave = wid < 4; const int wb = wid & 3;
    const int arow = OFF_A + (wr * 32 + fr) * 64 + (fq & 1) * 8;
    const int asl = (((fq >> 1) ^ ((fr >> 2) & 3)) * 16);
    const int boff = OFF_B2 + (wc * 64 + fr) * BP + fq * 8;
    const int hl = lane >> 5, c4 = lane & 31;
    unsigned wofs_c[2];
#pragma unroll
    for (int j = 0; j < 2; ++j) { const int col = 4 * c4 + 2 * hl + j; int slot;
        if (UP) { const int up = col >> 6, g = col & 63; slot = (g >> 5) * 64 + (up * 2 + ((g >> 4) & 1)) * 16 + (g & 15); } else slot = col;
        wofs_c[j] = (unsigned)(OFF_B2 + slot * BP + 8 * wb); }
    const int rro_c = OFF_R2 + (wb * 4) * 1024 + c4 * 16 + hl * 8;
    const unsigned ldsA = (unsigned)(size_t)(lds + OFF_A), ldsR = (unsigned)(size_t)(lds + OFF_R2);
    const int per = G >> 3, xcd = c & 7, rank = c >> 3;
    for (int ui = 0;; ++ui) {
        const int L = (ui * 8 + xcd) * per + rank; if (L >= NE * 16 || rank >= per) break;
        const int e = tstart[80 + (L >> 4)], slab = L & 15, slot0 = tstart[e] * 128, nsub_total = tstart[e + 1] - tstart[e];
        const float* bsrc;
        if (UP) bsrc = (c4 < 16 ? W0 : W1) + (size_t)e * wexp + slab * 64 + 4 * (c4 & 15); else bsrc = W0 + (size_t)e * wexp + slab * 128 + 4 * c4;
        bsrc += (size_t)(8 * wb + hl) * ldb;
        for (int sub0 = 0; sub0 < nsub_total; sub0 += MAXSUB) {
            const int nsub = (nsub_total - sub0) < MAXSUB ? (nsub_total - sub0) : MAXSUB;
            const int ce = cnts[e];
            const int rows_valid = (ce - sub0 * 128) < nsub * 128 ? (ce - sub0 * 128) : nsub * 128;
            unsigned voff[10];
#pragma unroll
            for (int i = 0; i < 10; ++i) { const int q = wb + 4 * i; int idx = 0;
                if (awave && q * 16 < rows_valid) { const int lrow = sub0 * 128 + 16 * q + (lane >> 2); idx = ltok ? (lrow < ce ? ltok[e * T + lrow] : 0) : slot0 + lrow; }
                voff[i] = (unsigned)(idx * lda + (((lane & 3) ^ ((lane >> 4) & 3)) * 16)); }
            if (!awave) { voff[0] = wofs_c[0]; voff[1] = wofs_c[1]; voff[2] = (unsigned)rro_c; voff[3] = (unsigned)(size_t)bsrc; voff[4] = (unsigned)((size_t)bsrc >> 32); }
            f32x4 acc[MAXSUB][2][4];
#pragma unroll
            for (int s = 0; s < MAXSUB; ++s)
#pragma unroll
                for (int m = 0; m < 2; ++m)
#pragma unroll
                    for (int n = 0; n < 4; ++n) acc[s][m][n] = (f32x4){0.f, 0.f, 0.f, 0.f};
#define M6_DMA_A(ds, TT) do { const char* _sb = (const char*)Abase + (size_t)(TT) * 64; _Pragma("unroll") for (int _i = 0; _i < 10; ++_i) if ((wb + 4 * _i) * 16 < rows_valid) \
        mg2::dma16_s(_sb, voff[_i], ldsA + (unsigned)((ds) * DSTG + (wb + 4 * _i) * 1024)); } while (0)
#define M6_DMA_B(rs, t) do { _Pragma("unroll") for (int _i = 0; _i < 4; ++_i) \
        dma16_v_nt((const float*)(((size_t)voff[4] << 32) | voff[3]) + (size_t)(32 * (t) + 2 * _i) * ldb, ldsR + (unsigned)((rs) * RSLOT + (wb * 4 + _i) * 1024)); } while (0)
#define M6_CVT_LOAD(rs) do { _Pragma("unroll") for (int _i = 0; _i < 4; ++_i) _Pragma("unroll") for (int _h = 0; _h < 2; ++_h) rv[2 * _i + _h] = *(const LAS f32x2*)(lds + voff[2] + (rs) * RSLOT + _i * 1024 + _h * 512); } while (0)
#define M6_CVT_STORE(stage) do { _Pragma("unroll") for (int _j = 0; _j < 2; ++_j) { u32x2 _w; _w.x = pk4_fp8(rv[0][_j] * WSCALE, rv[1][_j] * WSCALE, rv[2][_j] * WSCALE, rv[3][_j] * WSCALE); \
            _w.y = pk4_fp8(rv[4][_j] * WSCALE, rv[5][_j] * WSCALE, rv[6][_j] * WSCALE, rv[7][_j] * WSCALE); *(LAS u32x2*)(lds + (stage) * BSTG + voff[_j]) = _w; } } while (0)
            f32x2 rv[8];
#pragma unroll
            for (int i = 0; i < 8; ++i) rv[i] = (f32x2){0.f, 0.f};
            if (awave) { M6_DMA_A(0, 0); }
            else { M6_DMA_B(0, 0); M6_DMA_B(1, 1); M6_DMA_B(2, 2); asm volatile("s_waitcnt vmcnt(8)" ::: "memory"); M6_CVT_LOAD(0); M6_CVT_STORE(0); asm volatile("s_waitcnt lgkmcnt(0)" ::: "memory");
                   M6_DMA_B(0, 3); asm volatile("s_waitcnt vmcnt(8)" ::: "memory"); M6_CVT_LOAD(1); }
            int r1 = 1, r2 = 2;
            for (int t = 0; t < nt; ++t) {
                const int st = t & 1, TT = t >> 1, ds = TT & 1, tn4 = t + 4 < nt ? t + 4 : nt - 1;
                if (awave && st == 0) asm volatile("s_waitcnt vmcnt(0)" ::: "memory");
                asm volatile("s_waitcnt lgkmcnt(0)" ::: "memory"); __builtin_amdgcn_s_barrier(); asm volatile("" ::: "memory");
                if (awave) { if (st == 0) { const int Tn = TT + 1 < (nt >> 1) ? TT + 1 : (nt >> 1) - 1; M6_DMA_A(ds ^ 1, Tn); } }
                else { M6_CVT_STORE(st ^ 1); M6_DMA_B(r1, tn4); }
                long Bf[4];
#pragma unroll
                for (int n = 0; n < 4; ++n) Bf[n] = *(const LAS long*)(lds + st * BSTG + boff + n * 16 * BP);
                const int abase = ds * DSTG + arow + (asl ^ (st * 32));
#pragma unroll
                for (int s = 0; s < MAXSUB; ++s) if (s * 128 + wr * 32 < rows_valid) {
                    long Af[2];
#pragma unroll
                    for (int m = 0; m < 2; ++m) Af[m] = *(const LAS long*)(lds + abase + (s * 128 + m * 16) * 64);
                    __builtin_amdgcn_s_setprio(1);
#pragma unroll
                    for (int m = 0; m < 2; ++m)
#pragma unroll
                        for (int n = 0; n < 4; ++n) acc[s][m][n] = __builtin_amdgcn_mfma_f32_16x16x32_fp8_fp8(Bf[n], Af[m], acc[s][m][n], 0, 0, 0);
                    __builtin_amdgcn_s_setprio(0);
                }
                if (!awave) { asm volatile("s_waitcnt vmcnt(8)" ::: "memory"); M6_CVT_LOAD(r2); }
                r1 = r1 == 2 ? 0 : r1 + 1; r2 = r2 == 2 ? 0 : r2 + 1;
            }
            asm volatile("s_waitcnt vmcnt(0)" ::: "memory"); asm volatile("s_waitcnt lgkmcnt(0)" ::: "memory"); __builtin_amdgcn_s_barrier(); asm volatile("" ::: "memory");
            Unit u{slab, slot0 + sub0 * 128, rows_valid, e * T + sub0 * 128};
            E(acc, u, wr, wc, fr, fq);
#undef M6_DMA_A
#undef M6_DMA_B
#undef M6_CVT_LOAD
#undef M6_CVT_STORE
        }
    }
}

constexpr int OFF_B4 = 2 * DSTG  , OFF_R4 = OFF_B4 + 4 * BSTG  , LDS_END4 = OFF_R4 + 3 * RSLOT  ;
template <bool UP, class Epi>
__device__ __forceinline__ void gemm64x2(LAS unsigned char* lds, const unsigned char* Abase, int lda, const int* ltok, int K, int ldb, const float* W0, const float* W1, size_t wexp,
                                         const LAS int* tstart, const LAS int* cnts, int G, int c, const Epi& E) {
    const int tid = threadIdx.x, wid = __builtin_amdgcn_readfirstlane(tid >> 6), lane = tid & 63, wr = wid >> 1, wc = wid & 1, fr = lane & 15, fq = lane >> 4;
    const int nt = K / 32, nd = nt >> 1;
    const bool awave = wid < 4; const int wb = wid & 3;
    const int arow = OFF_A + (wr * 32 + fr) * 64 + (fq & 1) * 8;
    const int asl = (((fq >> 1) ^ ((fr >> 2) & 3)) * 16);
    const int boff = OFF_B4 + (wc * 64 + fr) * BP + fq * 8;
    const int hl = lane >> 5, c4 = lane & 31;
    unsigned wofs_c[2];
#pragma unroll
    for (int j = 0; j < 2; ++j) { const int col = 4 * c4 + 2 * hl + j; int slot;
        if (UP) { const int up = col >> 6, g = col & 63; slot = (g >> 5) * 64 + (up * 2 + ((g >> 4) & 1)) * 16 + (g & 15); } else slot = col;
        wofs_c[j] = (unsigned)(OFF_B4 + slot * BP + 8 * wb); }
    const int rro_c = OFF_R4 + (wb * 4) * 1024 + c4 * 16 + hl * 8;
    const unsigned ldsA = (unsigned)(size_t)(lds + OFF_A), ldsR = (unsigned)(size_t)(lds + OFF_R4);
    const int per = G >> 3, xcd = c & 7, rank = c >> 3;
    for (int ui = 0;; ++ui) {
        const int L = (ui * 8 + xcd) * per + rank; if (L >= NE * 16 || rank >= per) break;
        const int e = tstart[80 + (L >> 4)], slab = L & 15, slot0 = tstart[e] * 128, nsub_total = tstart[e + 1] - tstart[e];
        const float* bsrc;
        if (UP) bsrc = (c4 < 16 ? W0 : W1) + (size_t)e * wexp + slab * 64 + 4 * (c4 & 15); else bsrc = W0 + (size_t)e * wexp + slab * 128 + 4 * c4;
        bsrc += (size_t)(8 * wb + hl) * ldb;
        for (int sub0 = 0; sub0 < nsub_total; sub0 += MAXSUB) {
            const int nsub = (nsub_total - sub0) < MAXSUB ? (nsub_total - sub0) : MAXSUB;
            const int ce = cnts[e];
            const int rows_valid = (ce - sub0 * 128) < nsub * 128 ? (ce - sub0 * 128) : nsub * 128;
            unsigned voff[10];
#pragma unroll
            for (int i = 0; i < 10; ++i) { const int q = wb + 4 * i; int idx = 0;
                if (awave && q * 16 < rows_valid) { const int lrow = sub0 * 128 + 16 * q + (lane >> 2); idx = ltok ? (lrow < ce ? ltok[e * T + lrow] : 0) : slot0 + lrow; }
                voff[i] = (unsigned)(idx * lda + (((lane & 3) ^ ((lane >> 4) & 3)) * 16)); }
            if (!awave) { voff[0] = wofs_c[0]; voff[1] = wofs_c[1]; voff[2] = (unsigned)rro_c; voff[3] = (unsigned)(size_t)bsrc; voff[4] = (unsigned)((size_t)bsrc >> 32); }
            f32x4 acc[MAXSUB][2][4];
#pragma unroll
            for (int s = 0; s < MAXSUB; ++s)
#pragma unroll
                for (int m = 0; m < 2; ++m)
#pragma unroll
                    for (int n = 0; n < 4; ++n) acc[s][m][n] = (f32x4){0.f, 0.f, 0.f, 0.f};
#define M8_DMA_A(ds, TT) do { const char* _sb = (const char*)Abase + (size_t)(TT) * 64; _Pragma("unroll") for (int _i = 0; _i < 10; ++_i) if ((wb + 4 * _i) * 16 < rows_valid) \
        mg2::dma16_s(_sb, voff[_i], ldsA + (unsigned)((ds) * DSTG + (wb + 4 * _i) * 1024)); } while (0)
#define M8_DMA_B(rs, t) do { const int _t = (t) < nt ? (t) : nt - 1; _Pragma("unroll") for (int _i = 0; _i < 4; ++_i) \
        dma16_v_nt((const float*)(((size_t)voff[4] << 32) | voff[3]) + (size_t)(32 * _t + 2 * _i) * ldb, ldsR + (unsigned)((rs) * RSLOT + (wb * 4 + _i) * 1024)); } while (0)
#define M8_CVT_LOAD(rs) do { _Pragma("unroll") for (int _i = 0; _i < 4; ++_i) _Pragma("unroll") for (int _h = 0; _h < 2; ++_h) rv[2 * _i + _h] = *(const LAS f32x2*)(lds + voff[2] + (rs) * RSLOT + _i * 1024 + _h * 512); } while (0)
#define M8_CVT_STORE(stage) do { _Pragma("unroll") for (int _j = 0; _j < 2; ++_j) { u32x2 _w; _w.x = pk4_fp8(rv[0][_j] * WSCALE, rv[1][_j] * WSCALE, rv[2][_j] * WSCALE, rv[3][_j] * WSCALE); \
            _w.y = pk4_fp8(rv[4][_j] * WSCALE, rv[5][_j] * WSCALE, rv[6][_j] * WSCALE, rv[7][_j] * WSCALE); *(LAS u32x2*)(lds + (stage) * BSTG + voff[_j]) = _w; } } while (0)
#define M8_MMA(stage, half) do { long Bf[4]; _Pragma("unroll") for (int n = 0; n < 4; ++n) Bf[n] = *(const LAS long*)(lds + (stage) * BSTG + boff + n * 16 * BP); \
        const int abase = ds * DSTG + arow + (asl ^ ((half) * 32)); \
        _Pragma("unroll") for (int s = 0; s < MAXSUB; ++s) if (s * 128 + wr * 32 < rows_valid) { long Af[2]; \
            _Pragma("unroll") for (int m = 0; m < 2; ++m) Af[m] = *(const LAS long*)(lds + abase + (s * 128 + m * 16) * 64); \
            __builtin_amdgcn_s_setprio(1); \
            _Pragma("unroll") for (int m = 0; m < 2; ++m) _Pragma("unroll") for (int n = 0; n < 4; ++n) acc[s][m][n] = __builtin_amdgcn_mfma_f32_16x16x32_fp8_fp8(Bf[n], Af[m], acc[s][m][n], 0, 0, 0); \
            __builtin_amdgcn_s_setprio(0); } } while (0)
            f32x2 rv[8];
#pragma unroll
            for (int i = 0; i < 8; ++i) rv[i] = (f32x2){0.f, 0.f};
            if (awave) { M8_DMA_A(0, 0); }
            else { M8_DMA_B(0, 0); M8_DMA_B(1, 1); M8_DMA_B(2, 2);
                   asm volatile("s_waitcnt vmcnt(8)" ::: "memory"); M8_CVT_LOAD(0); M8_CVT_STORE(0); asm volatile("s_waitcnt lgkmcnt(0)" ::: "memory"); M8_DMA_B(0, 3);
                   asm volatile("s_waitcnt vmcnt(8)" ::: "memory"); M8_CVT_LOAD(1); M8_CVT_STORE(1); asm volatile("s_waitcnt lgkmcnt(0)" ::: "memory"); M8_DMA_B(1, 4);
                   asm volatile("s_waitcnt vmcnt(8)" ::: "memory"); M8_CVT_LOAD(2); }
            int m3 = 0;
            for (int TT = 0; TT < nd; ++TT) {
                const int ds = TT & 1, s0 = (TT & 1) * 2;
                const int m3p1 = m3 == 2 ? 0 : m3 + 1, m3p2 = m3 == 0 ? 2 : m3 - 1;
                if (awave) asm volatile("s_waitcnt vmcnt(0)" ::: "memory");
                asm volatile("s_waitcnt lgkmcnt(0)" ::: "memory"); __builtin_amdgcn_s_barrier(); asm volatile("" ::: "memory");
                if (awave) { const int Tn = TT + 1 < nd ? TT + 1 : nd - 1; M8_DMA_A(ds ^ 1, Tn); }
                else { M8_CVT_STORE(s0 ^ 2); M8_DMA_B(m3p2, 2 * TT + 5); }
                M8_MMA(s0, 0);
                if (!awave) { asm volatile("s_waitcnt vmcnt(8)" ::: "memory"); M8_CVT_LOAD(m3); M8_CVT_STORE((s0 ^ 2) + 1); asm volatile("s_waitcnt lgkmcnt(0)" ::: "memory"); M8_DMA_B(m3, 2 * TT + 6); }
                M8_MMA(s0 + 1, 1);
                if (!awave) { asm volatile("s_waitcnt vmcnt(8)" ::: "memory"); M8_CVT_LOAD(m3p1); }
                m3 = m3p2;
            }
            asm volatile("s_waitcnt vmcnt(0)" ::: "memory"); asm volatile("s_waitcnt lgkmcnt(0)" ::: "memory"); __builtin_amdgcn_s_barrier(); asm volatile("" ::: "memory");
            Unit u{slab, slot0 + sub0 * 128, rows_valid, e * T + sub0 * 128};
            E(acc, u, wr, wc, fr, fq);
#undef M8_DMA_A
#undef M8_DMA_B
#undef M8_CVT_LOAD
#undef M8_CVT_STORE
#undef M8_MMA
        }
    }
}
}
struct EpiSwiglu8 {
    unsigned char* actq; const float* slot_rs;
    __device__ __forceinline__ void operator()(const f32x4 (&acc)[mg3::MAXSUB][2][4], const mg3::Unit& u, int wr, int wc, int fr, int fq) const {
        float rsv[mg3::MAXSUB][2];
#pragma unroll
        for (int s = 0; s < mg3::MAXSUB; ++s)
#pragma unroll
            for (int m = 0; m < 2; ++m) rsv[s][m] = (s * 128 + wr * 32 + m * 16 < u.rows_valid) ? slot_rs[u.lbase + s * 128 + wr * 32 + m * 16 + fr] : 0.f;
#pragma unroll
        for (int s = 0; s < mg3::MAXSUB; ++s)
#pragma unroll
            for (int m = 0; m < 2; ++m) if (s * 128 + wr * 32 + m * 16 < u.rows_valid) { const int lr = s * 128 + wr * 32 + m * 16 + fr, row = u.row0 + lr; const float rs = rsv[s][m] * mg3::WINV;
                unsigned pq[2];
#pragma unroll
                for (int n = 0; n < 2; ++n) { const f32x4 g = acc[s][m][n] * rs, v = acc[s][m][n + 2] * rs; float o[4];
#pragma unroll
                    for (int j = 0; j < 4; ++j) o[j] = clamp448(g[j] * fast_sigmoid(g[j]) * v[j]);
                    pq[n] = pk4_fp8(o[0], o[1], o[2], o[3]); }
                const u32x2 sw = __builtin_amdgcn_permlane16_swap(pq[0], pq[1], false, false);
                *(u32x2*)(actq + (size_t)row * DE + u.slab * 64 + wc * 32 + (fq & 1) * 16 + (fq >> 1) * 8) = sw; }
    }
};
struct EpiDown8 {
    unsigned char* yq; const float* slot_w;
    __device__ __forceinline__ void operator()(const f32x4 (&acc)[mg3::MAXSUB][2][4], const mg3::Unit& u, int wr, int wc, int fr, int fq) const {
        float swv[mg3::MAXSUB][2];
#pragma unroll
        for (int s = 0; s < mg3::MAXSUB; ++s)
#pragma unroll
            for (int m = 0; m < 2; ++m) swv[s][m] = (s * 128 + wr * 32 + m * 16 < u.rows_valid) ? slot_w[u.lbase + s * 128 + wr * 32 + m * 16 + fr] : 0.f;
#pragma unroll
        for (int s = 0; s < mg3::MAXSUB; ++s)
#pragma unroll
            for (int m = 0; m < 2; ++m) if (s * 128 + wr * 32 + m * 16 < u.rows_valid) { const int lr = s * 128 + wr * 32 + m * 16 + fr, row = u.row0 + lr; const float sw = swv[s][m] * (mg3::WINV * 16.f);
                unsigned r[4];
#pragma unroll
                for (int n = 0; n < 4; ++n) { const f32x4 v = acc[s][m][n] * sw; r[n] = pk4_fp8(clamp448(v[0]), clamp448(v[1]), clamp448(v[2]), clamp448(v[3])); }
                const u32x2 a02 = __builtin_amdgcn_permlane32_swap(r[0], r[2], false, false), a13 = __builtin_amdgcn_permlane32_swap(r[1], r[3], false, false);
                const u32x2 b01 = __builtin_amdgcn_permlane16_swap(a02.x, a13.x, false, false), b23 = __builtin_amdgcn_permlane16_swap(a02.y, a13.y, false, false);
                u32x4 o; o.x = b01.x; o.y = b01.y; o.z = b23.x; o.w = b23.y;
                *(u32x4*)(yq + (size_t)row * D + u.slab * 128 + wc * 64 + 16 * fq) = o; }
    }
};
constexpr int PH_PROLOGUE = 0, PH_GEMM1 = 1, PH_GMLP = 2, PH_H1 = 3, PH_H2 = 4, PH_H3 = 5, PH_PAB = 6, PH_OUT = 7, PH_ROUTE = 8, PH_ASSIGN = 9, PH_MOEUP = 10, PH_MOEDN = 11, PH_FINAL = 12, PH_END = 13;
__global__ void __launch_bounds__(NTHR, 2) mega(Args args) {
    extern __shared__ __attribute__((aligned(16))) unsigned char lds_raw[];
    Frame F;
    F.lds = (LAS unsigned char*)lds_raw; F.MISC = (volatile LAS unsigned*)(F.lds + MISC_OFF);
    F.tid = threadIdx.x; F.lane = F.tid & 63; F.wave = __builtin_amdgcn_readfirstlane(F.tid >> 6);
    F.G = gridDim.x; F.bid = blockIdx.x; F.a = &args; F.ws = args.ws;
    unsigned char* ws = args.ws;
    for (int u = F.tid; u < (LDS_BYTES - RING_BYTES) / 4; u += NTHR) ((LAS unsigned*)(F.lds + RING_BYTES))[u] = 0u;
    __syncthreads();
    XcdBarrier bar = xcd_barrier_post((unsigned*)(ws + WS_CTL) + CW_BAR, F.MISC + 8);
    const int lo = args.ph_lo, hi = args.ph_hi;
#define IN(k) (lo <= (k) && (k) < hi)
#define SEAM(k) do { if (IN(k) && IN((k) + 1)) xcd_barrier(bar); } while (0)

    if (IN(PH_PROLOGUE)) { build_router_weights(F); p0_prologue(F, TR_ITEMS_SMALL); }
    SEAM(PH_PROLOGUE);
    if (IN(PH_GEMM1)) {
        pg8::Shape g{D, D, D}; pg8::StaticOrder S; S.init(ws + WS_H, ws + WS_WTIN, T, NZ, D, D, F.G, F.bid);
        EpiZ E{ws, args.in[7]};
        pg8::gemm_phase<EpiZ, pg8::StaticOrder>(F.lds, g, S, E);
    }
    SEAM(PH_GEMM1);
    if (IN(PH_GMLP)) { gmlp_phase(F); }
    if (IN(PH_H1)) { hgrn_h1_phase(F); }
    SEAM(PH_H1);
    if (IN(PH_H2)) { hgrn_h2_phase(F); }
    SEAM(PH_H2);
    if (IN(PH_H3)) { hgrn_h3_phase(F); }
    SEAM(PH_H3);
    if (IN(PH_PAB)) {
        pg8::Shape g{2048, 2048, 2048}; pg8::StaticOrder S; S.init(ws + WS_YAB, ws + WS_WTPAB, T, D, 2048, 2048, F.G, F.bid);
        EpiMerge E{(const bf16_t*)(ws + WS_SGA), (const bf16_t*)(ws + WS_SGB), (bf16_t*)(ws + WS_MERGED)};
        pg8::gemm_phase<EpiMerge, pg8::StaticOrder>(F.lds, g, S, E);
    }
    SEAM(PH_PAB);
    if (IN(PH_OUT)) {
        pg8::Shape g{D, D, D}; pg8::StaticOrder S; S.init(ws + WS_MERGED, ws + WS_WTOUT, T, D, D, D, F.G, F.bid);
        EpiRes E{args.in[0], (bf16_t*)(ws + WS_YAB)};
        pg8::gemm_phase<EpiRes, pg8::StaticOrder>(F.lds, g, S, E);
    }
    SEAM(PH_OUT);
    if (IN(PH_ROUTE)) { route_phase(F); }
    SEAM(PH_ROUTE);
    if (IN(PH_MOEUP)) {
        LAS int* tstart = (LAS int*)(F.lds + RING_BYTES - 1024); moe_tile_table128(F, tstart);
        EpiSwiglu8 E{ws + WS_ACT, (const float*)(ws + WS_LRS)};
        mg3::gemm64x2<true, EpiSwiglu8>(F.lds, ws + WS_H, D, (const int*)(ws + WS_LTOK), D, DE, args.in[17], args.in[18], (size_t)D * DE, tstart, tstart + 160, F.G, F.bid, E);
    }
    SEAM(PH_MOEUP);
    if (IN(PH_MOEDN)) {
        LAS int* tstart = (LAS int*)(F.lds + RING_BYTES - 1024); moe_tile_table128(F, tstart);
        EpiDown8 E{ws + WS_YB, (const float*)(ws + WS_LW)};
        mg3::gemm64x2<false, EpiDown8>(F.lds, ws + WS_ACT, DE, nullptr, DE, D, args.in[19], args.in[19], (size_t)DE * D, tstart, tstart + 160, F.G, F.bid, E);
    }
    SEAM(PH_MOEDN);
    if (IN(PH_FINAL)) { final_phase(F); }
#undef IN
#undef SEAM
}
}

extern "C" void kernel_launch(void* const* d_in, const int* in_sizes, int n_in, void* d_out, int out_size, void* d_ws, size_t ws_size, hipStream_t stream) {
    static int grid = 0;
    if (grid == 0) {
        int dev = 0, cus = 0, per_cu = 0;
        if (hipGetDevice(&dev) != hipSuccess || hipDeviceGetAttribute(&cus, hipDeviceAttributeMultiprocessorCount, dev) != hipSuccess) { fprintf(stderr, "kernel_launch: device query failed\n"); grid = -1; return; }
        if (hipFuncSetAttribute((const void*)mega, hipFuncAttributeMaxDynamicSharedMemorySize, LDS_BYTES) != hipSuccess) { fprintf(stderr, "kernel_launch: hipFuncSetAttribute failed\n"); grid = -1; return; }
        if (hipOccupancyMaxActiveBlocksPerMultiprocessor(&per_cu, (const void*)mega, NTHR, LDS_BYTES) != hipSuccess || per_cu < 1) fprintf(stderr, "kernel_launch: occupancy query reports %d\n", per_cu);
        (void)hipGetLastError();
        grid = cus;
    }
    if (grid < 0) return;
    const float* x = (const float*)d_in[0];
    float* out = (float*)d_out;
    unsigned char* ws = (unsigned char*)d_ws;
    if (ws_size < WS_END) { fprintf(stderr, "kernel_launch: workspace too small (%zu)\n", ws_size); return; }
    (void)hipMemsetAsync(ws + WS_CTL, 0, CTL_ZERO_BYTES, stream);
    Args a{};
    for (int i = 0; i < 21; ++i) a.in[i] = (const float*)d_in[i];
    a.out = out; a.ws = ws;
    auto launch = [&](int lo, int hi) { a.ph_lo = lo; a.ph_hi = hi; hipLaunchKernelGGL(mega, dim3(grid), dim3(NTHR), LDS_BYTES, stream, a); };
    launch(0, PH_END);
}
```
